# Optimizing an MI355X kernel written in HIP

```python
import math
import jax, jax.numpy as jnp
from jax import lax
import numpy as np

D_MODEL = 1024
BATCH = 8
SEQ = 2048
DEPTH = 4

GRID_W = 64
CTX_LEN = 256
MIX = 256
N_BRANCH = 4
RET_HEADS = 4
RET_HEAD_DIM = MIX // RET_HEADS
CHUNK = 128
POOL_WINDOWS = (2, 4, 8, 16)
POOL_GROUP = MIX // len(POOL_WINDOWS)
FFT_GROUPS = 4
FFT_GROUP_DIM = MIX // FFT_GROUPS
D_FF = -(-8 * D_MODEL // (3 * 256)) * 256
IN_WIDTH = 9 * MIX + N_BRANCH * D_MODEL
ROPE_BASE = 10000.0
EPS = 1e-6

kernel_name = 'hybrid_retention_conv_fourier_pool_dit_block'


def rmsnorm(x, g):
    xf = x.astype(jnp.float32)
    y = xf * lax.rsqrt(jnp.mean(xf * xf, axis=-1, keepdims=True) + EPS)
    return (y * g.astype(jnp.float32)).astype(x.dtype)


def rope_1d(x, pos):
    half = x.shape[-1] // 2
    freqs = ROPE_BASE ** (-jnp.arange(half, dtype=jnp.float32) / half)
    ang = pos[:, None] * freqs[None, :]
    cos, sin = jnp.cos(ang), jnp.sin(ang)
    x1, x2 = x[..., :half], x[..., half:]
    return jnp.concatenate([x1 * cos - x2 * sin, x1 * sin + x2 * cos], axis=-1)


def rope_2d(x, rows, cols):
    half = x.shape[-1] // 2
    return jnp.concatenate([rope_1d(x[..., :half], rows), rope_1d(x[..., half:], cols)], axis=-1)


def heads(t):
    b, n, _ = t.shape
    return t.reshape(b, n, RET_HEADS, RET_HEAD_DIM).transpose(0, 2, 1, 3).astype(jnp.float32)


def retention_direction(q, k, v, log_g, s0, strict):
    b, h, n, dk = q.shape
    dv = v.shape[-1]
    nc = n // CHUNK
    idx = jnp.arange(CHUNK, dtype=jnp.float32)
    diff = idx[:, None] - idx[None, :]
    mask = (diff > 0) if strict else (diff >= 0)
    intra = jnp.where(mask[None], jnp.exp(log_g[:, None, None] * jnp.maximum(diff, 0.0)[None]), 0.0)
    q_decay = jnp.exp(log_g[:, None] * (idx + 1.0)[None])[None, :, :, None]
    k_decay = jnp.exp(log_g[:, None] * (CHUNK - 1.0 - idx)[None])[None, :, :, None]
    chunk_decay = jnp.exp(log_g * CHUNK)[None, :, None, None]

    def to_chunks(t):
        return jnp.moveaxis(t.reshape(b, h, nc, CHUNK, t.shape[-1]), 2, 0)

    def step(state, inp):
        qc, kc, vc = inp
        scores = jnp.einsum('bhid,bhjd->bhij', qc, kc) * intra[None]
        out = (jnp.einsum('bhij,bhjv->bhiv', scores, vc)
               + jnp.einsum('bhid,bhdv->bhiv', qc, state) * q_decay)
        state = state * chunk_decay + jnp.einsum('bhjd,bhjv->bhdv', kc * k_decay, vc)
        return state, out

    state, ys = lax.scan(step, s0, (to_chunks(q), to_chunks(k), to_chunks(v)))
    return jnp.moveaxis(ys, 0, 2).reshape(b, h, n, dv), state


def bidirectional_retention(q, k, v, log_g, s_fwd0, s_bwd0):
    y_f, s_f = retention_direction(q, k, v, log_g[0], s_fwd0, False)
    flip = lambda t: t[:, :, ::-1]
    y_b, s_b = retention_direction(flip(q), flip(k), flip(v), log_g[1], s_bwd0, True)
    return y_f + flip(y_b), s_f, s_b


def retention_output(y, g):
    mu = jnp.mean(y, axis=-1, keepdims=True)
    var = jnp.mean(jnp.square(y - mu), axis=-1, keepdims=True)
    y = (y - mu) * lax.rsqrt(var + EPS)
    b, h, n, d = y.shape
    y = y.transpose(0, 2, 1, 3).reshape(b, n, h * d)
    return (y * jax.nn.silu(g.astype(jnp.float32))).astype(g.dtype)


def short_conv(p, conv_w):
    bg, cg, xv = p[..., 4 * MIX:5 * MIX], p[..., 5 * MIX:6 * MIX], p[..., 6 * MIX:7 * MIX]
    u = jnp.pad(cg * xv, ((0, 0), (1, 1), (0, 0)))
    conv = u[:, :-2] * conv_w[0] + u[:, 1:-1] * conv_w[1] + u[:, 2:] * conv_w[2]
    return bg * conv


def fourier_mix(u):
    b, n, _ = u.shape
    z = jnp.fft.fft2(u.astype(jnp.float32).reshape(b, n, FFT_GROUPS, FFT_GROUP_DIM), axes=(1, 3), norm='ortho')
    return jnp.real(z).reshape(b, n, MIX).astype(u.dtype)


def multiscale_pool(u, pool_w, pool_scale):
    b, n, _ = u.shape
    uf = u.astype(jnp.float32)
    csum = jnp.concatenate([jnp.zeros((b, 1, MIX), jnp.float32), jnp.cumsum(uf, axis=1)], axis=1)
    t = jnp.arange(n)
    outs = []
    for gi, w in enumerate(POOL_WINDOWS):
        lo = jnp.clip(t - w // 2, 0, n)
        hi = jnp.clip(t - w // 2 + w, 0, n)
        sl = slice(gi * POOL_GROUP, (gi + 1) * POOL_GROUP)
        cs = csum[:, :, sl]
        mean = (cs[:, hi] - cs[:, lo]) / (hi - lo).astype(jnp.float32)[None, :, None]
        outs.append(mean - uf[:, :, sl])
    pooled = jnp.stack(outs, axis=2)
    mixed = jnp.einsum('bngi,gio->bngo', pooled, pool_w.astype(jnp.float32)).reshape(b, n, MIX)
    return (mixed * pool_scale.astype(jnp.float32)).astype(u.dtype)


def mixer_output(p, ret_y, conv_w, pool_w, pool_scale, w_branch, w_o):
    branches = (retention_output(ret_y, p[..., 3 * MIX:4 * MIX]),
                short_conv(p, conv_w),
                fourier_mix(p[..., 7 * MIX:8 * MIX]),
                multiscale_pool(p[..., 8 * MIX:9 * MIX], pool_w, pool_scale))
    gates = jax.nn.sigmoid(p[..., 9 * MIX:])
    merged = 0.0
    for i, br in enumerate(branches):
        merged = merged + gates[..., i * D_MODEL:(i + 1) * D_MODEL] * (br @ w_branch[i])
    return merged @ w_o


def swiglu(h, w_up, w_down):
    a, u = jnp.split(h @ w_up, 2, axis=-1)
    return (jax.nn.silu(a) * u) @ w_down


def setup_inputs(seed: int = 0) -> dict:
    key = jax.random.key(seed)
    ks = jax.random.split(key, 16)
    nrm = lambda k, shape, s: jax.random.normal(k, shape, jnp.float32) * s
    base_decay = jnp.asarray(np.log(2.0 ** (5 + np.arange(RET_HEADS)) - 1.0).astype(np.float32))
    return {
        'x': nrm(ks[0], (BATCH, SEQ, D_MODEL), 1.0),
        'c': nrm(ks[1], (BATCH, D_MODEL), 1.0),
        'ctx': nrm(ks[2], (BATCH, CTX_LEN, D_MODEL), 1.0),
        'c_ctx': nrm(ks[3], (D_MODEL,), 1.0),
        'w_mod': nrm(ks[4], (DEPTH, D_MODEL, 6 * D_MODEL), 0.5 * D_MODEL ** -0.5),
        'b_mod': nrm(ks[5], (DEPTH, 6 * D_MODEL), 0.02),
        'norm_g': 1.0 + nrm(ks[6], (DEPTH, 4, D_MODEL), 0.02),
        'w_in': nrm(ks[7], (DEPTH, D_MODEL, IN_WIDTH), D_MODEL ** -0.5),
        'ret_decay': base_decay[None, None, :] + nrm(ks[8], (DEPTH, 2, RET_HEADS), 0.1),
        'conv_w': nrm(ks[9], (DEPTH, 3, MIX), 3 ** -0.5),
        'pool_w': nrm(ks[10], (DEPTH, len(POOL_WINDOWS), POOL_GROUP, POOL_GROUP), POOL_GROUP ** -0.5),
        'pool_scale': 1.0 + nrm(ks[11], (DEPTH, MIX), 0.02),
        'w_branch': nrm(ks[12], (DEPTH, N_BRANCH, MIX, D_MODEL), MIX ** -0.5),
        'w_o': nrm(ks[13], (DEPTH, D_MODEL, D_MODEL), D_MODEL ** -0.5),
        'ffn_w_up': nrm(ks[14], (DEPTH, D_MODEL, 2 * D_FF), D_MODEL ** -0.5),
        'ffn_w_down': nrm(ks[15], (DEPTH, D_FF, D_MODEL), D_FF ** -0.5),
    }


def reference(x, c, ctx, c_ctx, w_mod, b_mod, norm_g, w_in, ret_decay, conv_w, pool_w,
              pool_scale, w_branch, w_o, ffn_w_up, ffn_w_down):
    n = x.shape[1]
    ROWS = n // GRID_W
    rows = jnp.repeat(jnp.arange(ROWS, dtype=jnp.float32), GRID_W)
    cols = jnp.tile(jnp.arange(GRID_W, dtype=jnp.float32), ROWS)
    silu_c = jax.nn.silu(c)
    silu_cc = jax.nn.silu(c_ctx)
    scale_q = RET_HEAD_DIM ** -0.5
    for l in range(DEPTH):
        need_ctx = l < DEPTH - 1
        mod_l = (silu_c @ w_mod[l] + b_mod[l])[:, None, :]
        mod_c = (silu_cc @ w_mod[l] + b_mod[l])[None, None, :]
        sh1, sc1, g1, sh2, sc2, g2 = jnp.split(mod_l, 6, axis=-1)
        csh1, csc1, cg1, csh2, csc2, cg2 = jnp.split(mod_c, 6, axis=-1)

        h_lat = rmsnorm(x, norm_g[l, 0]) * (1.0 + sc1) + sh1
        h_ctx = rmsnorm(ctx, norm_g[l, 0]) * (1.0 + csc1) + csh1
        p_lat = h_lat @ w_in[l]
        p_ctx = h_ctx @ w_in[l]

        log_g = jax.nn.log_sigmoid(ret_decay[l].astype(jnp.float32))
        q_l = rope_2d(heads(p_lat[..., 0:MIX]) * scale_q, rows, cols)
        k_l = rope_2d(heads(p_lat[..., MIX:2 * MIX]), rows, cols)
        v_l = heads(p_lat[..., 2 * MIX:3 * MIX])
        q_c = heads(p_ctx[..., 0:MIX]) * scale_q
        k_c = heads(p_ctx[..., MIX:2 * MIX])
        v_c = heads(p_ctx[..., 2 * MIX:3 * MIX])
        s0 = jnp.zeros((x.shape[0], RET_HEADS, RET_HEAD_DIM, RET_HEAD_DIM), jnp.float32)
        y_c, s_f, s_b = bidirectional_retention(q_c, k_c, v_c, log_g, s0, s0)
        y_l, _, _ = bidirectional_retention(q_l, k_l, v_l, log_g, s_f, s_b)

        mix_lat = mixer_output(p_lat, y_l, conv_w[l], pool_w[l], pool_scale[l], w_branch[l], w_o[l])
        x = x + g1 * rmsnorm(mix_lat, norm_g[l, 1])
        h = rmsnorm(x, norm_g[l, 2]) * (1.0 + sc2) + sh2
        x = x + g2 * rmsnorm(swiglu(h, ffn_w_up[l], ffn_w_down[l]), norm_g[l, 3])

        if need_ctx:
            mix_ctx = mixer_output(p_ctx, y_c, conv_w[l], pool_w[l], pool_scale[l], w_branch[l], w_o[l])
            ctx = ctx + cg1 * rmsnorm(mix_ctx, norm_g[l, 1])
            hc = rmsnorm(ctx, norm_g[l, 2]) * (1.0 + csc2) + csh2
            ctx = ctx + cg2 * rmsnorm(swiglu(hc, ffn_w_up[l], ffn_w_down[l]), norm_g[l, 3])
    return x
```

```cpp
#include <hip/hip_runtime.h>
#include <hip/hip_cooperative_groups.h>
#include <stdint.h>
#include <stdio.h>
namespace cg = cooperative_groups;

#ifndef MULTI_LAUNCH
#define MULTI_LAUNCH 1
#endif

typedef unsigned short bf16_t;
typedef __attribute__((ext_vector_type(8))) short bf16x8;
typedef __attribute__((ext_vector_type(4))) float f32x4;

constexpr int DM = 1024, NBATCH = 8, SEQ = 2048, CTXL = 256, DEPTH = 4;
constexpr int MLAT = NBATCH * SEQ;
constexpr int MCTX = NBATCH * CTXL;
constexpr int MTOT = MLAT + MCTX;
constexpr int PW = 6144;
constexpr int W1ROWS = 6656;
constexpr int DFF = 2816;
constexpr int INW = 6400;
constexpr int NITEM = 576;
constexpr float EPSV = 1e-6f;
constexpr size_t ACT_OFF = (size_t)40 * 1024 * 1024;
constexpr int NPHASE = 2 + DEPTH * 10;

struct Params {
  const float *x, *c, *ctx, *c_ctx, *w_mod, *b_mod, *norm_g, *w_in, *ret_decay, *conv_w, *pool_w, *pool_scale,
      *w_branch, *w_o, *ffn_up, *ffn_down;
  float* out;
  bf16_t *W1T, *WbT, *WoT, *WupT, *WdT, *Tlat, *Tctx, *P, *H, *BR, *FTlat, *FTctx, *ST;
  float *rope, *KV, *xc, *mod;
};

__device__ __forceinline__ int tidx() {
  int t = threadIdx.x;
  asm volatile("" : "+v"(t));
  return t;
}
__device__ __forceinline__ unsigned short f2bf(float f) {
  unsigned u = __float_as_uint(f);
  u += 0x7fffu + ((u >> 16) & 1u);
  return (unsigned short)(u >> 16);
}
__device__ __forceinline__ float bf2f(unsigned short h) { return __uint_as_float(((unsigned)h) << 16); }
__device__ __forceinline__ unsigned pack2(float a, float b) { return (unsigned)f2bf(a) | ((unsigned)f2bf(b) << 16); }
__device__ __forceinline__ float lo2f(unsigned u) { return __uint_as_float(u << 16); }
__device__ __forceinline__ float hi2f(unsigned u) { return __uint_as_float(u & 0xffff0000u); }
__device__ __forceinline__ float sigmoid_(float x) { return 1.f / (1.f + __expf(-x)); }
__device__ __forceinline__ float silu_(float x) { return x / (1.f + __expf(-x)); }

__device__ __forceinline__ void unpack8(uint4 v, float* o) {
  o[0] = lo2f(v.x); o[1] = hi2f(v.x); o[2] = lo2f(v.y); o[3] = hi2f(v.y);
  o[4] = lo2f(v.z); o[5] = hi2f(v.z); o[6] = lo2f(v.w); o[7] = hi2f(v.w);
}
__device__ __forceinline__ uint4 pack8(const float* o) {
  uint4 v;
  v.x = pack2(o[0], o[1]); v.y = pack2(o[2], o[3]); v.z = pack2(o[4], o[5]); v.w = pack2(o[6], o[7]);
  return v;
}

__device__ __forceinline__ int lds_off(int row, int ch) { return row * 128 + ((ch ^ ((row >> 1) & 7)) << 4); }

__device__ __forceinline__ void zero_acc(f32x4 (&acc)[4][4]) {
#pragma unroll
  for (int i = 0; i < 4; ++i)
#pragma unroll
    for (int j = 0; j < 4; ++j) acc[i][j] = f32x4{0.f, 0.f, 0.f, 0.f};
}

__device__ __forceinline__ void gemm128(const bf16_t* __restrict__ A, int lda, const bf16_t* __restrict__ B, int ldb,
                                        int K, f32x4 (&acc)[4][4], char* smem) {
  const int tid = tidx(), lane = tid & 63, w = tid >> 6, wm = w >> 1, wn = w & 1;
  const int lr = lane & 15, lq = lane >> 4;
  const int srow = tid >> 3, sch = tid & 7;
  uint4 ra[4], rb[4];
  const bf16_t* ap = A + (size_t)srow * lda + sch * 8;
  const bf16_t* bp = B + (size_t)srow * ldb + sch * 8;
#pragma unroll
  for (int i = 0; i < 4; ++i) {
    ra[i] = *(const uint4*)(ap + (size_t)i * 32 * lda);
    rb[i] = *(const uint4*)(bp + (size_t)i * 32 * ldb);
  }
#pragma unroll
  for (int i = 0; i < 4; ++i) {
    *(uint4*)(smem + lds_off(srow + 32 * i, sch)) = ra[i];
    *(uint4*)(smem + 16384 + lds_off(srow + 32 * i, sch)) = rb[i];
  }
  __syncthreads();
  const int nk = K >> 6;
  for (int kt = 0; kt < nk; ++kt) {
    char* cur = smem + (kt & 1) * 32768;
    char* nxt = smem + ((kt + 1) & 1) * 32768;
    const bool more = (kt + 1 < nk);
    if (more) {
      ap += 64; bp += 64;
#pragma unroll
      for (int i = 0; i < 4; ++i) {
        ra[i] = *(const uint4*)(ap + (size_t)i * 32 * lda);
        rb[i] = *(const uint4*)(bp + (size_t)i * 32 * ldb);
      }
    }
#pragma unroll
    for (int ks = 0; ks < 2; ++ks) {
      bf16x8 af[4], bfr[4];
#pragma unroll
      for (int mi = 0; mi < 4; ++mi) af[mi] = *(const bf16x8*)(cur + lds_off(wm * 64 + mi * 16 + lr, ks * 4 + lq));
#pragma unroll
      for (int ni = 0; ni < 4; ++ni)
        bfr[ni] = *(const bf16x8*)(cur + 16384 + lds_off(wn * 64 + ni * 16 + lr, ks * 4 + lq));
#pragma unroll
      for (int mi = 0; mi < 4; ++mi)
#pragma unroll
        for (int ni = 0; ni < 4; ++ni)
          acc[mi][ni] = __builtin_amdgcn_mfma_f32_16x16x32_bf16(af[mi], bfr[ni], acc[mi][ni], 0, 0, 0);
    }
    if (more) {
#pragma unroll
      for (int i = 0; i < 4; ++i) {
        *(uint4*)(nxt + lds_off(srow + 32 * i, sch)) = ra[i];
        *(uint4*)(nxt + 16384 + lds_off(srow + 32 * i, sch)) = rb[i];
      }
    }
    __syncthreads();
  }
}

__device__ __forceinline__ void tile_decode(int t, int NT, int& mt, int& nt) {
  int g = t / (16 * NT), w = t % (16 * NT);
  mt = g * 16 + (w & 15);
  nt = w >> 4;
}

__device__ __forceinline__ void tr_tile(const float* __restrict__ src, int ld_src, int k0, int n0, bf16_t* __restrict__ dst,
                                        int ld_dst, int drow_base, int mode, float* tile) {
  const int tid = tidx();
#pragma unroll
  for (int i = 0; i < 4; ++i) {
    int k = (tid >> 4) + 16 * i, n4 = (tid & 15) * 4;
    float4 v = *(const float4*)(src + (size_t)(k0 + k) * ld_src + n0 + n4);
    tile[k * 65 + n4 + 0] = v.x; tile[k * 65 + n4 + 1] = v.y; tile[k * 65 + n4 + 2] = v.z; tile[k * 65 + n4 + 3] = v.w;
  }
  __syncthreads();
  const int n = tid >> 2, kseg = (tid & 3) * 16;
  float o[16];
#pragma unroll
  for (int j = 0; j < 16; ++j) o[j] = tile[(kseg + j) * 65 + n];
  int drow;
  if (mode == 0) drow = drow_base + n;
  else {
    int gn = n0 + n;
    int isu = gn >= DFF;
    int j = isu ? gn - DFF : gn;
    drow = (j >> 4) * 32 + isu * 16 + (j & 15);
  }
  bf16_t* d = dst + (size_t)drow * ld_dst + k0 + kseg;
  *(uint4*)d = pack8(o);
  *(uint4*)(d + 8) = pack8(o + 8);
  __syncthreads();
}

__device__ void convert_layer(const Params& p, int l, char* smem) {
  float* tile = (float*)smem;
  const int tid = tidx();
  const int U_IN = 16 * 96, U_BR = 192, U_O = 256, U_UP = 16 * 88, U_DN = 44 * 16, U_FF = 64, U_PF = 64;
  const int total = U_IN + U_BR + U_O + U_UP + U_DN + U_FF + U_PF;
  const float* w_in = p.w_in + (size_t)l * DM * INW;
  const float* w_br = p.w_branch + (size_t)l * 4 * 256 * DM;
  for (int u = blockIdx.x; u < total; u += gridDim.x) {
    int v = u;
    if (v < U_IN) {
      int kt = v & 15, ntile = v >> 4;
      int dn0 = ntile * 64;
      int sn0 = dn0 < 1792 ? dn0 : dn0 + 256;
      tr_tile(w_in, INW, kt * 64, sn0, p.W1T, 1024, dn0, 0, tile);
      continue;
    }
    v -= U_IN;
    if (v < U_BR) {
      int i = v / 64, r = v % 64, kt = r & 3, ntile = r >> 2;
      tr_tile(w_br + (size_t)i * 256 * DM, DM, kt * 64, ntile * 64, p.WbT + (size_t)i * 1024 * 256, 256, ntile * 64, 0, tile);
      continue;
    }
    v -= U_BR;
    if (v < U_O) {
      int kt = v & 15, ntile = v >> 4;
      tr_tile(p.w_o + (size_t)l * DM * DM, DM, kt * 64, ntile * 64, p.WoT, 1024, ntile * 64, 0, tile);
      continue;
    }
    v -= U_O;
    if (v < U_UP) {
      int kt = v & 15, ntile = v >> 4;
      tr_tile(p.ffn_up + (size_t)l * DM * 2 * DFF, 2 * DFF, kt * 64, ntile * 64, p.WupT, 1024, 0, 1, tile);
      continue;
    }
    v -= U_UP;
    if (v < U_DN) {
      int kt = v % 44, ntile = v / 44;
      tr_tile(p.ffn_down + (size_t)l * DFF * DM, DM, kt * 64, ntile * 64, p.WdT, DFF, ntile * 64, 0, tile);
      continue;
    }
    v -= U_DN;
    if (v < U_FF) {
      int g = v >> 4, kb = v & 15;
      float* tw = tile + 64 * 65;
#pragma unroll
      for (int i = 0; i < 4; ++i) {
        int k = (tid >> 4) + 16 * i, n4 = (tid & 15) * 4;
        float4 vv = *(const float4*)(w_in + (size_t)(kb * 64 + k) * INW + 1792 + g * 64 + n4);
        tile[k * 65 + n4 + 0] = vv.x; tile[k * 65 + n4 + 1] = vv.y; tile[k * 65 + n4 + 2] = vv.z; tile[k * 65 + n4 + 3] = vv.w;
      }
      if (tid < 64) { tw[tid] = cospif(tid / 32.f); tw[64 + tid] = sinpif(tid / 32.f); }
      __syncthreads();
      int kk = tid & 63, kg = tid >> 6;
#pragma unroll 1
      for (int q = 0; q < 16; ++q) {
        int k2 = kg * 16 + q;
        float sc = 0.f, ss = 0.f;
#pragma unroll 4
        for (int cch = 0; cch < 64; ++cch) {
          float wv = tile[kk * 65 + cch];
          int m = (cch * k2) & 63;
          sc += wv * tw[m];
          ss += wv * tw[64 + m];
        }
        p.W1T[(size_t)(6144 + g * 64 + k2) * 1024 + kb * 64 + kk] = f2bf(sc);
        p.W1T[(size_t)(6144 + 256 + g * 64 + k2) * 1024 + kb * 64 + kk] = f2bf(ss);
      }
      __syncthreads();
      continue;
    }
    v -= U_FF;
    {
      int g = v >> 4, ob = v & 15;
      float* pw = tile;
      float* wb = tile + 64 * 65;
      const float* pws = p.pool_w + ((size_t)l * 4 + g) * 64 * 64;
      const float* psc = p.pool_scale + (size_t)l * 256 + g * 64;
      const float* wsrc = w_br + (size_t)3 * 256 * DM + (size_t)(g * 64) * DM + ob * 64;
#pragma unroll
      for (int i = 0; i < 4; ++i) {
        int r = (tid >> 4) + 16 * i, n4 = (tid & 15) * 4;
        float4 a = *(const float4*)(pws + r * 64 + n4);
        pw[r * 65 + n4 + 0] = a.x * psc[n4 + 0]; pw[r * 65 + n4 + 1] = a.y * psc[n4 + 1];
        pw[r * 65 + n4 + 2] = a.z * psc[n4 + 2]; pw[r * 65 + n4 + 3] = a.w * psc[n4 + 3];
        float4 b = *(const float4*)(wsrc + (size_t)r * DM + n4);
        wb[r * 65 + n4 + 0] = b.x; wb[r * 65 + n4 + 1] = b.y; wb[r * 65 + n4 + 2] = b.z; wb[r * 65 + n4 + 3] = b.w;
      }
      __syncthreads();
      int ii = tid & 63, og = tid >> 6;
#pragma unroll 1
      for (int q = 0; q < 16; ++q) {
        int oc = og * 16 + q;
        float s = 0.f;
#pragma unroll 4
        for (int o = 0; o < 64; ++o) s += pw[ii * 65 + o] * wb[o * 65 + oc];
        p.WbT[((size_t)3 * 1024 + ob * 64 + oc) * 256 + g * 64 + ii] = f2bf(s);
      }
      __syncthreads();
    }
  }
}

__device__ void build_tables(const Params& p, char* smem) {
  const int tid = tidx();
  const int U_TW = 4096, U_TC = 64, U_RP = 256, U_MOD = 384;
  const int total = U_TW + U_TC + U_RP + U_MOD;
  for (int u = blockIdx.x; u < total; u += gridDim.x) {
    int v = u;
    if (v < U_TW) {
      size_t e0 = ((size_t)v * 256 + tid) * 8;
      int k1 = (int)(e0 >> 12), n0 = (int)(e0 & 4095);
      float o[8];
#pragma unroll
      for (int j = 0; j < 8; ++j) {
        int nn = n0 + j;
        int isn = nn >= 2048;
        int n = nn & 2047;
        int m = (k1 * n) & 2047;
        float fr = m * (1.f / 1024.f);
        o[j] = isn ? -sinpif(fr) : cospif(fr);
      }
      *(uint4*)(p.Tlat + e0) = pack8(o);
      continue;
    }
    v -= U_TW;
    if (v < U_TC) {
      size_t e0 = ((size_t)v * 256 + tid) * 8;
      int k1 = (int)(e0 >> 9), n0 = (int)(e0 & 511);
      float o[8];
#pragma unroll
      for (int j = 0; j < 8; ++j) {
        int nn = n0 + j;
        int isn = nn >= 256;
        int n = nn & 255;
        int m = (k1 * n) & 255;
        float fr = m * (1.f / 128.f);
        o[j] = isn ? -sinpif(fr) : cospif(fr);
      }
      *(uint4*)(p.Tctx + e0) = pack8(o);
      continue;
    }
    v -= U_TC;
    if (v < U_RP) {
      int e = v * 256 + tid;
      int n = e >> 5, i = e & 31;
      float freq = powf(10000.f, -(float)(i & 15) / 16.f);
      float pos = (i < 16) ? (float)(n >> 6) : (float)(n & 63);
      float ang = pos * freq;
      p.rope[n * 64 + i] = cosf(ang);
      p.rope[n * 64 + 32 + i] = sinf(ang);
      continue;
    }
    v -= U_RP;
    {
      int l = v / 96, cgp = v % 96;
      float* s = (float*)smem;
      float* red = s + 9 * 1024;
      for (int e = tid; e < 9 * 1024; e += 256) {
        float cv = (e < 8 * 1024) ? p.c[e] : p.c_ctx[e - 8 * 1024];
        s[e] = cv / (1.f + expf(-cv));
      }
      __syncthreads();
      int col = cgp * 64 + (tid & 63), kg = tid >> 6;
      float a[9];
#pragma unroll
      for (int r = 0; r < 9; ++r) a[r] = 0.f;
      const float* wm = p.w_mod + (size_t)l * DM * 6144 + col;
      for (int k = kg * 256; k < kg * 256 + 256; ++k) {
        float wv = wm[(size_t)k * 6144];
#pragma unroll
        for (int r = 0; r < 9; ++r) a[r] += s[r * 1024 + k] * wv;
      }
#pragma unroll
      for (int r = 0; r < 9; ++r) red[(kg * 9 + r) * 64 + (tid & 63)] = a[r];
      __syncthreads();
      for (int o = tid; o < 9 * 64; o += 256) {
        int r = o >> 6, cc = o & 63;
        float sum = red[(0 * 9 + r) * 64 + cc] + red[(1 * 9 + r) * 64 + cc] + red[(2 * 9 + r) * 64 + cc] +
                    red[(3 * 9 + r) * 64 + cc];
        p.mod[((size_t)l * 9 + r) * 6144 + cgp * 64 + cc] = sum + p.b_mod[(size_t)l * 6144 + cgp * 64 + cc];
      }
      __syncthreads();
    }
  }
}

__device__ __forceinline__ float wave_sum(float v) {
#pragma unroll
  for (int o = 32; o >= 1; o >>= 1) v += __shfl_xor(v, o, 64);
  return v;
}

__device__ void rowpass(const Params& p, int l, int mode) {
  const int lane = tidx() & 63;
  const int gw = blockIdx.x * 4 + (tidx() >> 6), nw = gridDim.x * 4;
  const bool ctx_on = (mode == 0) || (l < DEPTH - 1);
  const int nrows = ctx_on ? MTOT : MLAT;
  const float* raw = (const float*)p.P;
  const bool needh = !(mode == 2 && l == DEPTH - 1);
  const int lh = (mode == 2) ? l + 1 : l;
  for (int row = gw; row < nrows; row += nw) {
    const bool isl = row < MLAT;
    const int mrow = isl ? (row >> 11) : 8;
    const float* xin;
    float* xout;
    if (isl) {
      size_t o = (size_t)row * DM;
      xin = ((l == 0 && mode <= 1) ? p.x : p.out) + o;
      xout = p.out + o;
    } else {
      size_t o = (size_t)(row - MLAT) * DM;
      xin = ((l == 0 && mode <= 1) ? p.ctx : p.xc) + o;
      xout = p.xc + o;
    }
    float4 xv[4];
#pragma unroll
    for (int i = 0; i < 4; ++i) xv[i] = *(const float4*)(xin + lane * 4 + 256 * i);
    if (mode != 0) {
      const float* rr = raw + (size_t)row * DM;
      float4 rv[4];
      float ss = 0.f;
#pragma unroll
      for (int i = 0; i < 4; ++i) {
        rv[i] = *(const float4*)(rr + lane * 4 + 256 * i);
        ss += rv[i].x * rv[i].x + rv[i].y * rv[i].y + rv[i].z * rv[i].z + rv[i].w * rv[i].w;
      }
      ss = wave_sum(ss);
      float rstd = rsqrtf(ss * (1.f / DM) + EPSV);
      const float* ng = p.norm_g + ((size_t)l * 4 + (mode == 1 ? 1 : 3)) * DM;
      const float* gt = p.mod + ((size_t)l * 9 + mrow) * 6144 + (mode == 1 ? 2048 : 5120);
#pragma unroll
      for (int i = 0; i < 4; ++i) {
        float4 g4 = *(const float4*)(ng + lane * 4 + 256 * i);
        float4 t4 = *(const float4*)(gt + lane * 4 + 256 * i);
        xv[i].x += t4.x * (rv[i].x * rstd * g4.x);
        xv[i].y += t4.y * (rv[i].y * rstd * g4.y);
        xv[i].z += t4.z * (rv[i].z * rstd * g4.z);
        xv[i].w += t4.w * (rv[i].w * rstd * g4.w);
        *(float4*)(xout + lane * 4 + 256 * i) = xv[i];
      }
    }
    if (needh) {
      float ss = 0.f;
#pragma unroll
      for (int i = 0; i < 4; ++i) ss += xv[i].x * xv[i].x + xv[i].y * xv[i].y + xv[i].z * xv[i].z + xv[i].w * xv[i].w;
      ss = wave_sum(ss);
      float rstd = rsqrtf(ss * (1.f / DM) + EPSV);
      const float* ng = p.norm_g + ((size_t)lh * 4 + (mode == 1 ? 2 : 0)) * DM;
      const float* mv = p.mod + ((size_t)lh * 9 + mrow) * 6144 + (mode == 1 ? 3072 : 0);
      bf16_t* hr = p.H + (size_t)row * DM;
#pragma unroll
      for (int i = 0; i < 4; ++i) {
        float4 g4 = *(const float4*)(ng + lane * 4 + 256 * i);
        float4 sh = *(const float4*)(mv + lane * 4 + 256 * i);
        float4 sc = *(const float4*)(mv + 1024 + lane * 4 + 256 * i);
        float h0 = xv[i].x * rstd * g4.x * (1.f + sc.x) + sh.x;
        float h1 = xv[i].y * rstd * g4.y * (1.f + sc.y) + sh.y;
        float h2 = xv[i].z * rstd * g4.z * (1.f + sc.z) + sh.z;
        float h3 = xv[i].w * rstd * g4.w * (1.f + sc.w) + sh.w;
        uint2 pk;
        pk.x = pack2(h0, h1);
        pk.y = pack2(h2, h3);
        *(uint2*)(hr + lane * 4 + 256 * i) = pk;
      }
    }
  }
}

__device__ void phase_gemm1(const Params& p, int l, char* smem) {
  const bool lastl = (l == DEPTH - 1);
  const int nlat = 128 * 52;
  const int total = nlat + (lastl ? 64 : 16 * 52);
  const int lane = tidx() & 63, w = tidx() >> 6, wm = w >> 1, wn = w & 1, lr = lane & 15, lq = lane >> 4;
  for (int t = blockIdx.x; t < total; t += gridDim.x) {
    int mt, nt;
    if (t < nlat || !lastl) tile_decode(t, 52, mt, nt);
    else { int ww = t - nlat; mt = 128 + (ww & 15); nt = 2 + (ww >> 4); }
    f32x4 acc[4][4];
    zero_acc(acc);
    const bf16_t* Hm = p.H + (size_t)mt * 128 * 1024;
    if (nt < 48) {
      gemm128(p.W1T + (size_t)nt * 128 * 1024, 1024, Hm, 1024, 1024, acc, smem);
#pragma unroll
      for (int mi = 0; mi < 4; ++mi)
#pragma unroll
        for (int ni = 0; ni < 4; ++ni) {
          int n = nt * 128 + wm * 64 + mi * 16 + lq * 4;
          int tok = mt * 128 + wn * 64 + ni * 16 + lr;
          f32x4 v = acc[mi][ni];
          if (n >= 2048) { v[0] = sigmoid_(v[0]); v[1] = sigmoid_(v[1]); v[2] = sigmoid_(v[2]); v[3] = sigmoid_(v[3]); }
          uint2 pk;
          pk.x = pack2(v[0], v[1]);
          pk.y = pack2(v[2], v[3]);
          *(uint2*)(p.P + (size_t)tok * PW + n) = pk;
        }
    } else {
      int ft = nt - 48;
      gemm128(Hm, 1024, p.W1T + (size_t)(6144 + ft * 128) * 1024, 1024, 1024, acc, smem);
#pragma unroll
      for (int mi = 0; mi < 4; ++mi)
#pragma unroll
        for (int ni = 0; ni < 4; ++ni) {
          int tok = mt * 128 + wm * 64 + mi * 16 + lq * 4;
          int frow = ft * 128 + wn * 64 + ni * 16 + lr;
          int cs = frow >> 8, col = frow & 255;
          f32x4 v = acc[mi][ni];
          uint2 pk;
          pk.x = pack2(v[0], v[1]);
          pk.y = pack2(v[2], v[3]);
          if (tok < MLAT) {
            int b = tok >> 11, n = tok & 2047;
            *(uint2*)(p.FTlat + (((size_t)col * 8 + b) * 2 + cs) * 2048 + n) = pk;
          } else {
            int tk = tok - MLAT;
            int b = tk >> 8, n = tk & 255;
            *(uint2*)(p.FTctx + (((size_t)col * 8 + b) * 2 + cs) * 256 + n) = pk;
          }
        }
    }
  }
}

__device__ __forceinline__ void dft_tile(const Params& p, int u, char* smem) {
  const int lane = tidx() & 63, w = tidx() >> 6, wm = w >> 1, wn = w & 1, lr = lane & 15, lq = lane >> 4;
  f32x4 acc[4][4];
  zero_acc(acc);
  int b, ct, k1t, rowbase;
  float scale;
  if (u < 256) {
    b = u >> 5; ct = (u >> 4) & 1; k1t = u & 15;
    gemm128(p.FTlat + ((size_t)(ct * 128) * 8 + b) * 4096, 8 * 4096, p.Tlat + (size_t)(k1t * 128) * 4096, 4096, 4096, acc, smem);
    rowbase = b * 2048;
    scale = 0.00276213586400995f;
  } else {
    int v = u - 256;
    b = v >> 2; ct = (v >> 1) & 1; k1t = v & 1;
    gemm128(p.FTctx + ((size_t)(ct * 128) * 8 + b) * 512, 8 * 512, p.Tctx + (size_t)(k1t * 128) * 512, 512, 512, acc, smem);
    rowbase = MLAT + b * 256;
    scale = 0.0078125f;
  }
#pragma unroll
  for (int mi = 0; mi < 4; ++mi)
#pragma unroll
    for (int ni = 0; ni < 4; ++ni) {
      int col = ct * 128 + wm * 64 + mi * 16 + lq * 4;
      int k1 = k1t * 128 + wn * 64 + ni * 16 + lr;
      f32x4 v = acc[mi][ni];
      uint2 pk;
      pk.x = pack2(v[0] * scale, v[1] * scale);
      pk.y = pack2(v[2] * scale, v[3] * scale);
      *(uint2*)(p.BR + (size_t)(rowbase + k1) * 1024 + 512 + col) = pk;
    }
}

__device__ void phase_branch(const Params& p, int l, char* smem) {
  const int ntiles = ((l == DEPTH - 1) ? 128 : 144) * 8;
  const int lane = tidx() & 63, w = tidx() >> 6, wm = w >> 1, wn = w & 1, lr = lane & 15, lq = lane >> 4;
  for (int t = blockIdx.x; t < ntiles; t += gridDim.x) {
    int mt, nt;
    tile_decode(t, 8, mt, nt);
    f32x4 tot[4][4];
    zero_acc(tot);
    for (int i = 0; i < 4; ++i) {
      f32x4 acc[4][4];
      zero_acc(acc);
      gemm128(p.WbT + ((size_t)i * 1024 + nt * 128) * 256, 256, p.BR + (size_t)mt * 128 * 1024 + i * 256, 1024, 256, acc, smem);
#pragma unroll
      for (int mi = 0; mi < 4; ++mi)
#pragma unroll
        for (int ni = 0; ni < 4; ++ni) {
          int cc = nt * 128 + wm * 64 + mi * 16 + lq * 4;
          int tok = mt * 128 + wn * 64 + ni * 16 + lr;
          uint2 g = *(const uint2*)(p.P + (size_t)tok * PW + 2048 + i * 1024 + cc);
          tot[mi][ni][0] += lo2f(g.x) * acc[mi][ni][0];
          tot[mi][ni][1] += hi2f(g.x) * acc[mi][ni][1];
          tot[mi][ni][2] += lo2f(g.y) * acc[mi][ni][2];
          tot[mi][ni][3] += hi2f(g.y) * acc[mi][ni][3];
        }
    }
#pragma unroll
    for (int mi = 0; mi < 4; ++mi)
#pragma unroll
      for (int ni = 0; ni < 4; ++ni) {
        int cc = nt * 128 + wm * 64 + mi * 16 + lq * 4;
        int tok = mt * 128 + wn * 64 + ni * 16 + lr;
        uint2 pk;
        pk.x = pack2(tot[mi][ni][0], tot[mi][ni][1]);
        pk.y = pack2(tot[mi][ni][2], tot[mi][ni][3]);
        *(uint2*)(p.H + (size_t)tok * 1024 + cc) = pk;
      }
  }
}

__device__ void phase_proj(const Params& p, int l, int mode, char* smem) {
  const int ntiles = ((l == DEPTH - 1) ? 128 : 144) * 8;
  const int lane = tidx() & 63, w = tidx() >> 6, wm = w >> 1, wn = w & 1, lr = lane & 15, lq = lane >> 4;
  float* raw = (float*)p.P;
  const bf16_t* act = p.P + ACT_OFF;
  for (int t = blockIdx.x; t < ntiles; t += gridDim.x) {
    int mt, nt;
    tile_decode(t, 8, mt, nt);
    f32x4 acc[4][4];
    zero_acc(acc);
    if (mode == 0) gemm128(p.WoT + (size_t)nt * 128 * 1024, 1024, p.H + (size_t)mt * 128 * 1024, 1024, 1024, acc, smem);
    else gemm128(p.WdT + (size_t)nt * 128 * DFF, DFF, act + (size_t)mt * 128 * DFF, DFF, DFF, acc, smem);
#pragma unroll
    for (int mi = 0; mi < 4; ++mi)
#pragma unroll
      for (int ni = 0; ni < 4; ++ni) {
        int cc = nt * 128 + wm * 64 + mi * 16 + lq * 4;
        int tok = mt * 128 + wn * 64 + ni * 16 + lr;
        float4 o;
        o.x = acc[mi][ni][0]; o.y = acc[mi][ni][1]; o.z = acc[mi][ni][2]; o.w = acc[mi][ni][3];
        *(float4*)(raw + (size_t)tok * 1024 + cc) = o;
      }
  }
}

__device__ void phase_up(const Params& p, int l, char* smem) {
  const int ntiles = ((l == DEPTH - 1) ? 128 : 144) * 44;
  const int lane = tidx() & 63, w = tidx() >> 6, wm = w >> 1, wn = w & 1, lr = lane & 15, lq = lane >> 4;
  bf16_t* act = p.P + ACT_OFF;
  for (int t = blockIdx.x; t < ntiles; t += gridDim.x) {
    int mt, nt;
    tile_decode(t, 44, mt, nt);
    f32x4 acc[4][4];
    zero_acc(acc);
    gemm128(p.WupT + (size_t)nt * 128 * 1024, 1024, p.H + (size_t)mt * 128 * 1024, 1024, 1024, acc, smem);
#pragma unroll
    for (int mp = 0; mp < 2; ++mp)
#pragma unroll
      for (int ni = 0; ni < 4; ++ni) {
        int gidx = nt * 4 + wm * 2 + mp;
        int fcol = gidx * 16 + lq * 4;
        int tok = mt * 128 + wn * 64 + ni * 16 + lr;
        f32x4 a = acc[mp * 2][ni], uu = acc[mp * 2 + 1][ni];
        uint2 pk;
        pk.x = pack2(silu_(a[0]) * uu[0], silu_(a[1]) * uu[1]);
        pk.y = pack2(silu_(a[2]) * uu[2], silu_(a[3]) * uu[3]);
        *(uint2*)(act + (size_t)tok * DFF + fcol) = pk;
      }
  }
}

__device__ __forceinline__ void item_decode(int it, int& s, int& b, int& h, int& c, int& rowbase, int& pos0) {
  if (it < 512) { s = 0; b = it >> 6; h = (it >> 4) & 3; c = it & 15; rowbase = b * 2048 + c * 128; pos0 = c * 128; }
  else { int v = it - 512; s = 1; b = v >> 3; h = (v >> 1) & 3; c = v & 1; rowbase = MLAT + b * 256 + c * 128; pos0 = 0; }
}
__device__ __forceinline__ float log_sigmoid_(float x) { return -log1pf(expf(-x)); }

__device__ __forceinline__ void load_half(const bf16_t* g, float (&xv)[32]) {
#pragma unroll
  for (int q = 0; q < 4; ++q) unpack8(*(const uint4*)(g + q * 8), &xv[q * 8]);
}
__device__ __forceinline__ void rope_half(float (&xv)[32], const float* tab  ) {
#pragma unroll
  for (int q = 0; q < 4; ++q) {
    float4 c4 = *(const float4*)(tab + q * 4);
    float4 s4 = *(const float4*)(tab + 32 + q * 4);
    float cc[4] = {c4.x, c4.y, c4.z, c4.w}, sn[4] = {s4.x, s4.y, s4.z, s4.w};
#pragma unroll
    for (int e = 0; e < 4; ++e) {
      int i = q * 4 + e;
      float x1 = xv[i], x2 = xv[i + 16];
      xv[i] = x1 * cc[e] - x2 * sn[e];
      xv[i + 16] = x1 * sn[e] + x2 * cc[e];
    }
  }
}

__device__ __forceinline__ void ret_kv_item(const Params& p, int l, int it, char* smem) {
  const int tid = tidx(), lane = tid & 63, w = tid >> 6, lr = lane & 15, lq = lane >> 4;
  int s, b, h, c, rowbase, pos0;
  item_decode(it, s, b, h, c, rowbase, pos0);
  const float lgf = log_sigmoid_(p.ret_decay[(l * 2 + 0) * 4 + h]);
  const float lgb = log_sigmoid_(p.ret_decay[(l * 2 + 1) * 4 + h]);
  bf16_t* AT = (bf16_t*)smem;
  bf16_t* VT = AT + 128 * 136;
  {
    const int j = tid >> 1, half = tid & 1;
    const bf16_t* prow = p.P + (size_t)(rowbase + j) * PW;
    float kv[32];
    load_half(prow + 256 + h * 64 + half * 32, kv);
    if (s == 0) rope_half(kv, p.rope + (size_t)(pos0 + j) * 64 + half * 16);
    float df = expf(lgf * (float)(127 - j)), db = expf(lgb * (float)j);
#pragma unroll
    for (int e = 0; e < 32; ++e) {
      int d = half * 32 + e;
      AT[d * 136 + j] = f2bf(kv[e] * df);
      AT[(64 + d) * 136 + j] = f2bf(kv[e] * db);
    }
    const bf16_t* vsrc = prow + 512 + h * 64 + half * 32;
#pragma unroll
    for (int q = 0; q < 4; ++q) {
      uint4 vv = *(const uint4*)(vsrc + q * 8);
      unsigned uu[4] = {vv.x, vv.y, vv.z, vv.w};
#pragma unroll
      for (int e = 0; e < 4; ++e) {
        int d = half * 32 + q * 8 + e * 2;
        VT[d * 136 + j] = (bf16_t)(uu[e] & 0xffffu);
        VT[(d + 1) * 136 + j] = (bf16_t)(uu[e] >> 16);
      }
    }
  }
  __syncthreads();
  f32x4 acc[2][4];
#pragma unroll
  for (int mi = 0; mi < 2; ++mi)
#pragma unroll
    for (int ni = 0; ni < 4; ++ni) acc[mi][ni] = f32x4{0.f, 0.f, 0.f, 0.f};
#pragma unroll
  for (int ks = 0; ks < 4; ++ks) {
    bf16x8 af[2], bfr[4];
#pragma unroll
    for (int mi = 0; mi < 2; ++mi) af[mi] = *(const bf16x8*)(AT + (w * 32 + mi * 16 + lr) * 136 + ks * 32 + lq * 8);
#pragma unroll
    for (int ni = 0; ni < 4; ++ni) bfr[ni] = *(const bf16x8*)(VT + (ni * 16 + lr) * 136 + ks * 32 + lq * 8);
#pragma unroll
    for (int mi = 0; mi < 2; ++mi)
#pragma unroll
      for (int ni = 0; ni < 4; ++ni)
        acc[mi][ni] = __builtin_amdgcn_mfma_f32_16x16x32_bf16(af[mi], bfr[ni], acc[mi][ni], 0, 0, 0);
  }
  float* kvout = p.KV + (size_t)it * 2 * 4096;
#pragma unroll
  for (int mi = 0; mi < 2; ++mi)
#pragma unroll
    for (int ni = 0; ni < 4; ++ni) {
      int r = w * 32 + mi * 16 + lq * 4;
      int dir = r >> 6, d = r & 63;
      int v = ni * 16 + lr;
      float4 o;
      o.x = acc[mi][ni][0]; o.y = acc[mi][ni][1]; o.z = acc[mi][ni][2]; o.w = acc[mi][ni][3];
      *(float4*)(kvout + (size_t)dir * 4096 + v * 64 + d) = o;
    }
  __syncthreads();
}

__device__ void ret_scan(const Params& p, int l) {
  const int total = NBATCH * 4 * 2 * 4096;
  for (int e = blockIdx.x * 256 + tidx(); e < total; e += gridDim.x * 256) {
    int vd = e & 4095, dir = (e >> 12) & 1, h = (e >> 13) & 3, b = e >> 15;
    float lg = log_sigmoid_(p.ret_decay[(l * 2 + dir) * 4 + h]);
    float cd = expf(lg * 128.f);
    float S = 0.f;
    for (int st = 0; st < 18; ++st) {
      int it;
      if (dir == 0) it = (st < 2) ? 512 + ((b * 4 + h) * 2 + st) : ((b * 4 + h) * 16 + (st - 2));
      else it = (st < 2) ? 512 + ((b * 4 + h) * 2 + (1 - st)) : ((b * 4 + h) * 16 + (17 - st));
      size_t o = ((size_t)it * 2 + dir) * 4096 + vd;
      p.ST[o] = f2bf(S);
      S = S * cd + p.KV[o];
    }
  }
}

__device__ __forceinline__ void ret_out_item(const Params& p, int l, int it, char* smem) {
  const int tid = tidx(), lane = tid & 63, w = tid >> 6, lr = lane & 15, lq = lane >> 4;
  int s, b, h, c, rowbase, pos0;
  item_decode(it, s, b, h, c, rowbase, pos0);
  const float lgf = log_sigmoid_(p.ret_decay[(l * 2 + 0) * 4 + h]);
  const float lgb = log_sigmoid_(p.ret_decay[(l * 2 + 1) * 4 + h]);
  bf16_t* Qs = (bf16_t*)smem;
  bf16_t* Ks = Qs + 128 * 72;
  bf16_t* Ps = (bf16_t*)smem;
  bf16_t* VT = (bf16_t*)(smem + 36864);
  bf16_t* Ss = (bf16_t*)(smem + 54272);
  {
    const int j = tid >> 1, half = tid & 1;
    const bf16_t* prow = p.P + (size_t)(rowbase + j) * PW;
    const float* tab = p.rope + (size_t)(pos0 + j) * 64 + half * 16;
    float xv[32];
    load_half(prow + h * 64 + half * 32, xv);
    if (s == 0) rope_half(xv, tab);
#pragma unroll
    for (int e = 0; e < 32; ++e) xv[e] *= 0.125f;
#pragma unroll
    for (int q = 0; q < 4; ++q) *(uint4*)(Qs + j * 72 + half * 32 + q * 8) = pack8(&xv[q * 8]);
    load_half(prow + 256 + h * 64 + half * 32, xv);
    if (s == 0) rope_half(xv, tab);
#pragma unroll
    for (int q = 0; q < 4; ++q) *(uint4*)(Ks + j * 72 + half * 32 + q * 8) = pack8(&xv[q * 8]);
    const bf16_t* vsrc = prow + 512 + h * 64 + half * 32;
#pragma unroll
    for (int q = 0; q < 4; ++q) {
      uint4 vv = *(const uint4*)(vsrc + q * 8);
      unsigned uu[4] = {vv.x, vv.y, vv.z, vv.w};
#pragma unroll
      for (int e = 0; e < 4; ++e) {
        int d = half * 32 + q * 8 + e * 2;
        VT[d * 136 + j] = (bf16_t)(uu[e] & 0xffffu);
        VT[(d + 1) * 136 + j] = (bf16_t)(uu[e] >> 16);
      }
    }
    const bf16_t* st = p.ST + (size_t)it * 2 * 4096;
#pragma unroll
    for (int q = 0; q < 4; ++q) {
      int ch = tid + 256 * q;
      int rowi = ch >> 3, cc = ch & 7;
      *(uint4*)(Ss + rowi * 72 + cc * 8) = *(const uint4*)(st + (size_t)rowi * 64 + cc * 8);
    }
  }
  __syncthreads();
  const int i0 = w * 32;
  bf16x8 qf[2][2];
#pragma unroll
  for (int mi = 0; mi < 2; ++mi)
#pragma unroll
    for (int ks = 0; ks < 2; ++ks) qf[mi][ks] = *(const bf16x8*)(Qs + (i0 + mi * 16 + lr) * 72 + ks * 32 + lq * 8);
  f32x4 sacc[2][8];
#pragma unroll
  for (int mi = 0; mi < 2; ++mi)
#pragma unroll
    for (int nj = 0; nj < 8; ++nj) sacc[mi][nj] = f32x4{0.f, 0.f, 0.f, 0.f};
#pragma unroll
  for (int nj = 0; nj < 8; ++nj)
#pragma unroll
    for (int ks = 0; ks < 2; ++ks) {
      bf16x8 kf = *(const bf16x8*)(Ks + (nj * 16 + lr) * 72 + ks * 32 + lq * 8);
#pragma unroll
      for (int mi = 0; mi < 2; ++mi) sacc[mi][nj] = __builtin_amdgcn_mfma_f32_16x16x32_bf16(qf[mi][ks], kf, sacc[mi][nj], 0, 0, 0);
    }
  __syncthreads();
#pragma unroll
  for (int mi = 0; mi < 2; ++mi)
#pragma unroll
    for (int nj = 0; nj < 8; ++nj)
#pragma unroll
      for (int r = 0; r < 4; ++r) {
        int i = i0 + mi * 16 + lq * 4 + r, j = nj * 16 + lr;
        float dd = (i >= j) ? __expf(lgf * (float)(i - j)) : __expf(lgb * (float)(j - i));
        Ps[i * 136 + j] = f2bf(sacc[mi][nj][r] * dd);
      }
  __syncthreads();
  f32x4 accF[2][4], accB[2][4], acc1[2][4];
#pragma unroll
  for (int mi = 0; mi < 2; ++mi)
#pragma unroll
    for (int nv = 0; nv < 4; ++nv) {
      accF[mi][nv] = f32x4{0.f, 0.f, 0.f, 0.f};
      accB[mi][nv] = f32x4{0.f, 0.f, 0.f, 0.f};
      acc1[mi][nv] = f32x4{0.f, 0.f, 0.f, 0.f};
    }
#pragma unroll
  for (int nv = 0; nv < 4; ++nv)
#pragma unroll
    for (int ks = 0; ks < 2; ++ks) {
      bf16x8 sf = *(const bf16x8*)(Ss + (nv * 16 + lr) * 72 + ks * 32 + lq * 8);
      bf16x8 sb = *(const bf16x8*)(Ss + (64 + nv * 16 + lr) * 72 + ks * 32 + lq * 8);
#pragma unroll
      for (int mi = 0; mi < 2; ++mi) {
        accF[mi][nv] = __builtin_amdgcn_mfma_f32_16x16x32_bf16(qf[mi][ks], sf, accF[mi][nv], 0, 0, 0);
        accB[mi][nv] = __builtin_amdgcn_mfma_f32_16x16x32_bf16(qf[mi][ks], sb, accB[mi][nv], 0, 0, 0);
      }
    }
#pragma unroll
  for (int ks = 0; ks < 4; ++ks) {
    bf16x8 pf[2], vf[4];
#pragma unroll
    for (int mi = 0; mi < 2; ++mi) pf[mi] = *(const bf16x8*)(Ps + (i0 + mi * 16 + lr) * 136 + ks * 32 + lq * 8);
#pragma unroll
    for (int nv = 0; nv < 4; ++nv) vf[nv] = *(const bf16x8*)(VT + (nv * 16 + lr) * 136 + ks * 32 + lq * 8);
#pragma unroll
    for (int mi = 0; mi < 2; ++mi)
#pragma unroll
      for (int nv = 0; nv < 4; ++nv) acc1[mi][nv] = __builtin_amdgcn_mfma_f32_16x16x32_bf16(pf[mi], vf[nv], acc1[mi][nv], 0, 0, 0);
  }
#pragma unroll
  for (int mi = 0; mi < 2; ++mi)
#pragma unroll
    for (int r = 0; r < 4; ++r) {
      int i = i0 + mi * 16 + lq * 4 + r;
      float qd = __expf(lgf * (float)(i + 1)), qb = __expf(lgb * (float)(128 - i));
      float* yr = (float*)(smem + i * 272);
#pragma unroll
      for (int nv = 0; nv < 4; ++nv) yr[nv * 16 + lr] = acc1[mi][nv][r] + qd * accF[mi][nv][r] + qb * accB[mi][nv][r];
    }
  __syncthreads();
  {
    const int i = i0 + (lane >> 1), half = lane & 1;
    const float* yr = (const float*)(smem + i * 272) + half * 32;
    float y[32];
#pragma unroll
    for (int q = 0; q < 8; ++q) {
      float4 t4 = *(const float4*)(yr + q * 4);
      y[q * 4 + 0] = t4.x; y[q * 4 + 1] = t4.y; y[q * 4 + 2] = t4.z; y[q * 4 + 3] = t4.w;
    }
    float sum = 0.f;
#pragma unroll
    for (int e = 0; e < 32; ++e) sum += y[e];
    sum += __shfl_xor(sum, 1, 64);
    float mu = sum * (1.f / 64.f);
    float vs = 0.f;
#pragma unroll
    for (int e = 0; e < 32; ++e) { y[e] -= mu; vs += y[e] * y[e]; }
    vs += __shfl_xor(vs, 1, 64);
    float rstd = rsqrtf(vs * (1.f / 64.f) + EPSV);
    size_t row = (size_t)(rowbase + i);
    const bf16_t* gp = p.P + row * PW + 768 + h * 64 + half * 32;
    bf16_t* op = p.BR + row * 1024 + h * 64 + half * 32;
#pragma unroll
    for (int q = 0; q < 4; ++q) {
      float g8[8], o8[8];
      unpack8(*(const uint4*)(gp + q * 8), g8);
#pragma unroll
      for (int e = 0; e < 8; ++e) o8[e] = y[q * 8 + e] * rstd * silu_(g8[e]);
      *(uint4*)(op + q * 8) = pack8(o8);
    }
  }
  __syncthreads();
}

__device__ __forceinline__ void convpool_unit(const Params& p, int l, int u) {
  const int tid = tidx();
  const int row0 = u * 64;
  int seqstart, len;
  if (row0 < MLAT) { seqstart = (row0 >> 11) << 11; len = SEQ; }
  else { seqstart = MLAT + (((row0 - MLAT) >> 8) << 8); len = CTXL; }
  const float* cw = p.conv_w + (size_t)l * 3 * 256;
  for (int itx = 0; itx < 8; ++itx) {
    int idx = tid + 256 * itx;
    int tok = idx >> 5, cgp = idx & 31, ch = cgp * 8;
    int row = row0 + tok, tpos = row - seqstart;
    const bf16_t* pr = p.P + (size_t)row * PW;
    {
      float Bv[8], Cv[8], Xv[8], uc[8], up[8], un[8];
      unpack8(*(const uint4*)(pr + 1024 + ch), Bv);
      unpack8(*(const uint4*)(pr + 1280 + ch), Cv);
      unpack8(*(const uint4*)(pr + 1536 + ch), Xv);
#pragma unroll
      for (int e = 0; e < 8; ++e) uc[e] = Cv[e] * Xv[e];
      if (tpos > 0) {
        unpack8(*(const uint4*)(pr - PW + 1280 + ch), Cv);
        unpack8(*(const uint4*)(pr - PW + 1536 + ch), Xv);
#pragma unroll
        for (int e = 0; e < 8; ++e) up[e] = Cv[e] * Xv[e];
      } else {
#pragma unroll
        for (int e = 0; e < 8; ++e) up[e] = 0.f;
      }
      if (tpos < len - 1) {
        unpack8(*(const uint4*)(pr + PW + 1280 + ch), Cv);
        unpack8(*(const uint4*)(pr + PW + 1536 + ch), Xv);
#pragma unroll
        for (int e = 0; e < 8; ++e) un[e] = Cv[e] * Xv[e];
      } else {
#pragma unroll
        for (int e = 0; e < 8; ++e) un[e] = 0.f;
      }
      float o[8];
#pragma unroll
      for (int e = 0; e < 8; ++e)
        o[e] = Bv[e] * (up[e] * cw[ch + e] + uc[e] * cw[256 + ch + e] + un[e] * cw[512 + ch + e]);
      *(uint4*)(p.BR + (size_t)row * 1024 + 256 + ch) = pack8(o);
    }
    {
      int gi = ch >> 6;
      int wdw = 2 << gi;
      int lo = tpos - (wdw >> 1);
      int hi = lo + wdw;
      lo = lo < 0 ? 0 : lo;
      hi = hi > len ? len : hi;
      float sum[8], cur[8];
#pragma unroll
      for (int e = 0; e < 8; ++e) sum[e] = 0.f;
      const bf16_t* base = p.P + (size_t)seqstart * PW + 1792 + ch;
      for (int j = lo; j < hi; ++j) {
        float t8[8];
        unpack8(*(const uint4*)(base + (size_t)j * PW), t8);
#pragma unroll
        for (int e = 0; e < 8; ++e) sum[e] += t8[e];
      }
      unpack8(*(const uint4*)(pr + 1792 + ch), cur);
      float inv = 1.f / (float)(hi - lo);
      float o[8];
#pragma unroll
      for (int e = 0; e < 8; ++e) o[e] = sum[e] * inv - cur[e];
      *(uint4*)(p.BR + (size_t)row * 1024 + 768 + ch) = pack8(o);
    }
  }
}

__device__ void phase_mix_a(const Params& p, int l, char* smem) {
  const bool lastl = (l == DEPTH - 1);
  const int n_dft = lastl ? 256 : 288;
  const int n_cp = lastl ? 256 : 288;
  const int n_oth = NITEM + n_cp;
  for (int u = blockIdx.x; u < n_dft; u += gridDim.x) dft_tile(p, u, smem);
  for (int o = (gridDim.x - 1 - blockIdx.x); o < n_oth; o += gridDim.x) {
    if (o < NITEM) ret_kv_item(p, l, o, smem);
    else convpool_unit(p, l, o - NITEM);
  }
}

__device__ void phase_mix_c(const Params& p, int l, char* smem) {
  const int n = (l == DEPTH - 1) ? 512 : NITEM;
  for (int it = blockIdx.x; it < n; it += gridDim.x) ret_out_item(p, l, it, smem);
}

__device__ void run_phase(const Params& p, int ph, char* smem) {
  if (ph == 0) { convert_layer(p, 0, smem); build_tables(p, smem); return; }
  if (ph == 1) { rowpass(p, 0, 0); return; }
  int l = (ph - 2) / 10, k = (ph - 2) % 10;
  switch (k) {
    case 0: phase_gemm1(p, l, smem); break;
    case 1: phase_mix_a(p, l, smem); break;
    case 2: ret_scan(p, l); break;
    case 3: phase_mix_c(p, l, smem); break;
    case 4: phase_branch(p, l, smem); break;
    case 5: phase_proj(p, l, 0, smem); break;
    case 6: rowpass(p, l, 1); break;
    case 7: phase_up(p, l, smem); break;
    case 8: phase_proj(p, l, 1, smem); break;
    case 9:
      rowpass(p, l, 2);
      if (l + 1 < DEPTH) convert_layer(p, l + 1, smem);
      break;
  }
}

__global__ void __launch_bounds__(256, 2) mega(Params p, int ph_lo, int ph_hi) {
  __shared__ __attribute__((aligned(16))) char smem[72704];
  for (int ph = ph_lo; ph < ph_hi; ++ph) {
    run_phase(p, ph, smem);
    if (ph + 1 < ph_hi) cg::this_grid().sync();
  }
}

extern "C" void kernel_launch(void* const* d_in, const int* in_sizes, int n_in, void* d_out, int out_size, void* d_ws,
                              size_t ws_size, hipStream_t stream) {
  Params p{};
  p.x = (const float*)d_in[0]; p.c = (const float*)d_in[1]; p.ctx = (const float*)d_in[2]; p.c_ctx = (const float*)d_in[3];
  p.w_mod = (const float*)d_in[4]; p.b_mod = (const float*)d_in[5]; p.norm_g = (const float*)d_in[6];
  p.w_in = (const float*)d_in[7]; p.ret_decay = (const float*)d_in[8]; p.conv_w = (const float*)d_in[9];
  p.pool_w = (const float*)d_in[10]; p.pool_scale = (const float*)d_in[11]; p.w_branch = (const float*)d_in[12];
  p.w_o = (const float*)d_in[13]; p.ffn_up = (const float*)d_in[14]; p.ffn_down = (const float*)d_in[15];
  p.out = (float*)d_out;
  char* ws = (char*)d_ws;
  size_t off = 0;
  auto take = [&](size_t bytes) { char* r = ws + off; off += (bytes + 255) & ~(size_t)255; return r; };
  p.W1T = (bf16_t*)take((size_t)W1ROWS * 1024 * 2);
  p.WbT = (bf16_t*)take((size_t)4 * 1024 * 256 * 2);
  p.WoT = (bf16_t*)take((size_t)1024 * 1024 * 2);
  p.WupT = (bf16_t*)take((size_t)2 * DFF * 1024 * 2);
  p.WdT = (bf16_t*)take((size_t)1024 * DFF * 2);
  p.Tlat = (bf16_t*)take((size_t)2048 * 4096 * 2);
  p.Tctx = (bf16_t*)take((size_t)256 * 512 * 2);
  p.P = (bf16_t*)take((size_t)MTOT * PW * 2);
  p.H = (bf16_t*)take((size_t)MTOT * 1024 * 2);
  p.BR = (bf16_t*)take((size_t)MTOT * 1024 * 2);
  p.FTlat = (bf16_t*)take((size_t)256 * 8 * 2 * 2048 * 2);
  p.FTctx = (bf16_t*)take((size_t)256 * 8 * 2 * 256 * 2);
  p.ST = (bf16_t*)take((size_t)NITEM * 2 * 4096 * 2);
  p.rope = (float*)take((size_t)2048 * 64 * 4);
  p.KV = (float*)take((size_t)NITEM * 2 * 4096 * 4);
  p.xc = (float*)take((size_t)MCTX * 1024 * 4);
  p.mod = (float*)take((size_t)DEPTH * 9 * 6144 * 4);
  if (off > ws_size) { fprintf(stderr, "workspace too small: need %zu have %zu\n", off, ws_size); return; }

  static int grid_blocks = 0;
  if (!grid_blocks) {
    int dev = 0, cus = 0, per_cu = 0;
    (void)hipGetDevice(&dev);
    (void)hipDeviceGetAttribute(&cus, hipDeviceAttributeMultiprocessorCount, dev);
    (void)hipOccupancyMaxActiveBlocksPerMultiprocessor(&per_cu, (const void*)mega, 256, 0);
    if (per_cu < 1) per_cu = 1;
    if (per_cu > 2) per_cu = 2;
    grid_blocks = cus * per_cu;
  }
#if MULTI_LAUNCH
  for (int ph = 0; ph < NPHASE; ++ph) {
    hipLaunchKernelGGL(mega, dim3(grid_blocks), dim3(256), 0, stream, p, ph, ph + 1);
  }
#else
  int lo = 0, hi = NPHASE;
  void* args[] = {&p, &lo, &hi};
  hipError_t e = hipLaunchCooperativeKernel((const void*)mega, dim3(grid_blocks), dim3(256), args, 0, stream);
  if (e != hipSuccess) fprintf(stderr, "cooperative launch failed: %s (grid %d)\n", hipGetErrorString(e), grid_blocks);
#endif
}
```

```cpp
#include <hip/hip_runtime.h>
#include <hip/hip_cooperative_groups.h>
#include <stdint.h>
#include <stdio.h>
namespace cg = cooperative_groups;

#ifndef MULTI_LAUNCH
#define MULTI_LAUNCH 0
#endif

typedef unsigned short bf16_t;
typedef __attribute__((ext_vector_type(8))) short bf16x8;
typedef __attribute__((ext_vector_type(4))) float f32x4;

constexpr int DM = 1024, NBATCH = 8, SEQ = 2048, CTXL = 256, DEPTH = 4;
constexpr int MLAT = NBATCH * SEQ;
constexpr int MCTX = NBATCH * CTXL;
constexpr int MTOT = MLAT + MCTX;
constexpr int PW = 2048;
constexpr int W1ROWS = 6656;
constexpr int DFF = 2816;
constexpr int INW = 6400;
constexpr int NITEM = 576;
constexpr float EPSV = 1e-6f;
constexpr size_t ACT_OFF = (size_t)40 * 1024 * 1024;
constexpr int NPHASE = 2 + DEPTH * 10;
constexpr size_t WSET = (size_t)35127296 / 2;

struct Params {
  const float *x, *c, *ctx, *c_ctx, *w_mod, *b_mod, *norm_g, *w_in, *ret_decay, *conv_w, *pool_w, *pool_scale,
      *w_branch, *w_o, *ffn_up, *ffn_down;
  float* out;
  bf16_t *W1T, *WbT, *WoT, *WupT, *WdT, *Tlat, *Tctx, *P, *H, *BR, *FTlat, *FTctx, *ST;
  float *rope, *KV, *xc, *mod;
  unsigned* bar;
  uint4* GT;
};

__device__ __forceinline__ int tidx() {
  int t = threadIdx.x & 255;
  asm volatile("" : "+v"(t));
  return t;
}
__device__ __forceinline__ int tid512() {
  int t = threadIdx.x;
  asm volatile("" : "+v"(t));
  return t;
}
__device__ __forceinline__ int vbid() { return blockIdx.x * 2 + __builtin_amdgcn_readfirstlane(threadIdx.x >> 8); }
__device__ __forceinline__ int nvb() { return gridDim.x * 2; }
__device__ __forceinline__ unsigned short f2bf(float f) {
  unsigned u = __float_as_uint(f);
  u += 0x7fffu + ((u >> 16) & 1u);
  return (unsigned short)(u >> 16);
}
__device__ __forceinline__ float bf2f(unsigned short h) { return __uint_as_float(((unsigned)h) << 16); }
__device__ __forceinline__ unsigned pack2(float a, float b) {
  unsigned r;
  asm("v_cvt_pk_bf16_f32 %0, %1, %2" : "=v"(r) : "v"(a), "v"(b));
  return r;
}
__device__ __forceinline__ float lo2f(unsigned u) { return __uint_as_float(u << 16); }
__device__ __forceinline__ float hi2f(unsigned u) { return __uint_as_float(u & 0xffff0000u); }
__device__ __forceinline__ float sigmoid_(float x) { return __builtin_amdgcn_rcpf(1.f + __expf(-x)); }
__device__ __forceinline__ float silu_(float x) { return x * __builtin_amdgcn_rcpf(1.f + __expf(-x)); }

__device__ __forceinline__ void unpack8(uint4 v, float* o) {
  o[0] = lo2f(v.x); o[1] = hi2f(v.x); o[2] = lo2f(v.y); o[3] = hi2f(v.y);
  o[4] = lo2f(v.z); o[5] = hi2f(v.z); o[6] = lo2f(v.w); o[7] = hi2f(v.w);
}
__device__ __forceinline__ uint4 pack8(const float* o) {
  uint4 v;
  v.x = pack2(o[0], o[1]); v.y = pack2(o[2], o[3]); v.z = pack2(o[4], o[5]); v.w = pack2(o[6], o[7]);
  return v;
}

__device__ __forceinline__ int lds_off(int row, int ch) { return row * 128 + ((ch ^ ((row >> 1) & 7)) << 4); }

__device__ __forceinline__ void zero_acc(f32x4 (&acc)[4][4]) {
#pragma unroll
  for (int i = 0; i < 4; ++i)
#pragma unroll
    for (int j = 0; j < 4; ++j) acc[i][j] = f32x4{0.f, 0.f, 0.f, 0.f};
}

__device__ __forceinline__ void gemm128(const bf16_t* __restrict__ A, int lda, const bf16_t* __restrict__ B, int ldb,
                                        int K, f32x4 (&acc)[4][4], char* smem) {
  const int tid = tidx(), lane = tid & 63, w = tid >> 6, wm = w >> 1, wn = w & 1;
  const int lr = lane & 15, lq = lane >> 4;
  const int srow = tid >> 3, sch = tid & 7;
  uint4 ra[4], rb[4];
  const bf16_t* ap = A + (size_t)srow * lda + sch * 8;
  const bf16_t* bp = B + (size_t)srow * ldb + sch * 8;
#pragma unroll
  for (int i = 0; i < 4; ++i) {
    ra[i] = *(const uint4*)(ap + (size_t)i * 32 * lda);
    rb[i] = *(const uint4*)(bp + (size_t)i * 32 * ldb);
  }
#pragma unroll
  for (int i = 0; i < 4; ++i) {
    *(uint4*)(smem + lds_off(srow + 32 * i, sch)) = ra[i];
    *(uint4*)(smem + 16384 + lds_off(srow + 32 * i, sch)) = rb[i];
  }
  __syncthreads();
  const int nk = K >> 6;
  for (int kt = 0; kt < nk; ++kt) {
    char* cur = smem + (kt & 1) * 32768;
    char* nxt = smem + ((kt + 1) & 1) * 32768;
    const bool more = (kt + 1 < nk);
    if (more) {
      ap += 64; bp += 64;
#pragma unroll
      for (int i = 0; i < 4; ++i) {
        ra[i] = *(const uint4*)(ap + (size_t)i * 32 * lda);
        rb[i] = *(const uint4*)(bp + (size_t)i * 32 * ldb);
      }
    }
#pragma unroll
    for (int ks = 0; ks < 2; ++ks) {
      bf16x8 af[4], bfr[4];
#pragma unroll
      for (int mi = 0; mi < 4; ++mi) af[mi] = *(const bf16x8*)(cur + lds_off(wm * 64 + mi * 16 + lr, ks * 4 + lq));
#pragma unroll
      for (int ni = 0; ni < 4; ++ni)
        bfr[ni] = *(const bf16x8*)(cur + 16384 + lds_off(wn * 64 + ni * 16 + lr, ks * 4 + lq));
#pragma unroll
      for (int mi = 0; mi < 4; ++mi)
#pragma unroll
        for (int ni = 0; ni < 4; ++ni)
          acc[mi][ni] = __builtin_amdgcn_mfma_f32_16x16x32_bf16(af[mi], bfr[ni], acc[mi][ni], 0, 0, 0);
    }
    if (more) {
#pragma unroll
      for (int i = 0; i < 4; ++i) {
        *(uint4*)(nxt + lds_off(srow + 32 * i, sch)) = ra[i];
        *(uint4*)(nxt + 16384 + lds_off(srow + 32 * i, sch)) = rb[i];
      }
    }
    __syncthreads();
  }
}


#define PG8_LAS __attribute__((address_space(3)))
constexpr int G_BM = 256, G_BK = 64, G_HALF = 128, G_HTB = G_HALF * G_BK * 2;
__device__ __forceinline__ int g_lds_byte(int r, int c) { const int st = (r >> 4) * 2 + (c >> 5), rr = r & 15, cc = c & 31, ob = rr * 64 + cc * 2; return st * 1024 + (ob ^ (((ob >> 9) & 1) << 5)); }
__device__ __forceinline__ void g_stage_rc(int b, int& R, int& C) { const int st = b / 1024, sb = b % 1024, swz = sb ^ (((sb >> 9) & 1) << 5); R = (st >> 1) * 16 + swz / 64; C = (st & 1) * 32 + (swz % 64) / 2; }
__device__ __forceinline__ int g_perm32(int rho) { const int n = rho >> 4, i = rho & 15; return 8 * (i >> 2) + 4 * n + (i & 3); }
struct Unit { int pm, pn, kind; };

template <class Epi, class Sched>
__device__ __forceinline__ void gemm_phase(PG8_LAS unsigned char* lds, const int K, const int lda, const int ldb, const Sched& S, const Epi& E) {
  const int tid = tid512(), wid = __builtin_amdgcn_readfirstlane(tid >> 6), lane = tid & 63, wr = wid >> 2, wc = wid & 3, fr = lane & 15, fq = lane >> 4;
  const int nt = K / G_BK;
  unsigned voffA[2], voffB[2];
#pragma unroll
  for (int i = 0; i < 2; ++i) { int R, C; g_stage_rc(tid * 16 + i * 8192, R, C); const int Rb = Epi::PERM ? ((R & ~31) + g_perm32(R & 31)) : R;
    voffA[i] = (unsigned)(R * lda + C) * 2u; voffB[i] = (unsigned)(Rb * ldb + C) * 2u; }
  const size_t kstep = (size_t)(G_BK * 2);
  const size_t hstepA = (size_t)G_HALF * lda * 2, hstepB = (size_t)G_HALF * ldb * 2;
  const unsigned ldsw = (unsigned)wid * 1024u;
  const int aoff = g_lds_byte(wr * 64 + fr, fq * 8), boff = g_lds_byte(wc * 32 + fr, fq * 8);
#define PG8_SA(b, h) (((b) * 2 + (h)) * G_HTB)
#define PG8_SB(b, h) ((4 + (b) * 2 + (h)) * G_HTB)
#define PG8_STAGE(bufoff, gbase, voff) do { _Pragma("unroll") for (int _i = 0; _i < 2; ++_i) \
    __builtin_amdgcn_global_load_lds((const unsigned*)((const char*)(gbase) + (voff)[_i]), (PG8_LAS unsigned*)(lds + (bufoff) + ldsw + _i * 8192), 16, 0, 0); } while (0)
#define PG8_LDA(dst, b, h) do { _Pragma("unroll") for (int m = 0; m < 4; ++m) _Pragma("unroll") for (int k = 0; k < 2; ++k) dst[m][k] = *(const PG8_LAS bf16x8*)(lds + PG8_SA(b, h) + aoff + m * 2048 + k * 1024); } while (0)
#define PG8_LDB(dst, b, h) do { _Pragma("unroll") for (int n = 0; n < 2; ++n) _Pragma("unroll") for (int k = 0; k < 2; ++k) dst[n][k] = *(const PG8_LAS bf16x8*)(lds + PG8_SB(b, h) + boff + n * 2048 + k * 1024); } while (0)
#define PG8_MMA(ai, bj, At, Bt) do { __builtin_amdgcn_s_setprio(1); _Pragma("unroll") for (int m = 0; m < 4; ++m) _Pragma("unroll") for (int n = 0; n < 2; ++n) _Pragma("unroll") for (int k = 0; k < 2; ++k) \
    acc[ai][bj][m][n] = __builtin_amdgcn_mfma_f32_16x16x32_bf16(Bt[n][k], At[m][k], acc[ai][bj][m][n], 0, 0, 0); __builtin_amdgcn_s_setprio(0); } while (0)
#define PG8_WAIT_V(n) asm volatile("s_waitcnt vmcnt(" #n ")" ::: "memory")
#define PG8_WAIT_L(n) asm volatile("s_waitcnt lgkmcnt(" #n ")" ::: "memory")
#define PG8_BAR __builtin_amdgcn_s_barrier()
#define PG8_SCHED __builtin_amdgcn_sched_barrier(0)
  Unit cur, nxt; int ui = 0;
  const bool any = S.next(0, cur);
  if (any) {
    f32x4 acc[2][2][4][2];
#pragma unroll
    for (int a = 0; a < 2; ++a)
#pragma unroll
      for (int b = 0; b < 2; ++b)
#pragma unroll
        for (int m = 0; m < 4; ++m)
#pragma unroll
          for (int n = 0; n < 2; ++n) acc[a][b][m][n] = (f32x4){0.f, 0.f, 0.f, 0.f};
    bf16x8 At[4][2], B0[2][2], B1[2][2];
    const char* cA = S.aptr(cur); const char* cB = S.bptr(cur);
    PG8_WAIT_V(0);
    PG8_STAGE(PG8_SB(0, 0), cB, voffB); PG8_STAGE(PG8_SA(0, 0), cA, voffA); PG8_STAGE(PG8_SB(0, 1), cB + hstepB, voffB); PG8_STAGE(PG8_SA(0, 1), cA + hstepA, voffA);
    if (wr == 1) PG8_BAR;
    PG8_WAIT_V(4); PG8_BAR;
    PG8_STAGE(PG8_SB(1, 0), cB + kstep, voffB); PG8_STAGE(PG8_SA(1, 0), cA + kstep, voffA); PG8_STAGE(PG8_SB(1, 1), cB + hstepB + kstep, voffB);
    PG8_WAIT_V(6); PG8_BAR;
    for (;;) {
      const bool has_next = S.next(ui + 1, nxt);
      const char* nA = has_next ? S.aptr(nxt) : cA; const char* nB = has_next ? S.bptr(nxt) : cB;
      for (int t = 0; t < nt; t += 2) {
        const bool last = (t == nt - 2);
        const char* a1 = cA + (size_t)(t + 1) * kstep;
        const char* a2 = last ? nA : cA + (size_t)(t + 2) * kstep; const char* b2 = last ? nB : cB + (size_t)(t + 2) * kstep;
        const char* a3 = a2 + kstep; const char* b3 = b2 + kstep;
        PG8_LDB(B0, 0, 0); PG8_SCHED; PG8_LDA(At, 0, 0); PG8_STAGE(PG8_SA(1, 1), a1 + hstepA, voffA);
        PG8_WAIT_L(8); PG8_BAR; PG8_WAIT_L(0); PG8_MMA(0, 0, At, B0); PG8_BAR; PG8_SCHED;
        PG8_LDB(B1, 0, 1); PG8_STAGE(PG8_SB(0, 0), b2, voffB);
        PG8_BAR; PG8_WAIT_L(0); PG8_MMA(0, 1, At, B1); PG8_BAR;
        PG8_LDA(At, 0, 1); PG8_STAGE(PG8_SA(0, 0), a2, voffA);
        PG8_BAR; PG8_WAIT_L(0); PG8_MMA(1, 0, At, B0); PG8_BAR; PG8_SCHED;
        PG8_STAGE(PG8_SB(0, 1), b2 + hstepB, voffB);
        PG8_WAIT_V(6); PG8_BAR; PG8_MMA(1, 1, At, B1); PG8_BAR;
        PG8_LDB(B0, 1, 0); PG8_SCHED; PG8_LDA(At, 1, 0); PG8_STAGE(PG8_SA(0, 1), a2 + hstepA, voffA);
        PG8_WAIT_L(8); PG8_BAR; PG8_WAIT_L(0); PG8_MMA(0, 0, At, B0); PG8_BAR; PG8_SCHED;
        PG8_LDB(B1, 1, 1); PG8_STAGE(PG8_SB(1, 0), b3, voffB);
        PG8_BAR; PG8_WAIT_L(0); PG8_MMA(0, 1, At, B1); PG8_BAR;
        PG8_LDA(At, 1, 1); PG8_STAGE(PG8_SA(1, 0), a3, voffA);
        PG8_BAR; PG8_WAIT_L(0); PG8_MMA(1, 0, At, B0); PG8_BAR; PG8_SCHED;
        PG8_STAGE(PG8_SB(1, 1), b3 + hstepB, voffB);
        PG8_WAIT_V(6); PG8_BAR; PG8_MMA(1, 1, At, B1); PG8_BAR;
      }
      const bool do_reset = E(acc, cur, wr, wc, fr, fq);
      if (!has_next) break;
      if (do_reset) {
#pragma unroll
      for (int a = 0; a < 2; ++a)
#pragma unroll
        for (int b = 0; b < 2; ++b)
#pragma unroll
          for (int m = 0; m < 4; ++m)
#pragma unroll
            for (int n = 0; n < 2; ++n) acc[a][b][m][n] = (f32x4){0.f, 0.f, 0.f, 0.f};
      }
      cur = nxt; cA = nA; cB = nB; ++ui;
    }
    PG8_WAIT_V(0);
    if (wr == 0) PG8_BAR;
    PG8_BAR;
  }
#undef PG8_SA
#undef PG8_SB
#undef PG8_STAGE
#undef PG8_LDA
#undef PG8_LDB
#undef PG8_MMA
#undef PG8_WAIT_V
#undef PG8_WAIT_L
#undef PG8_BAR
#undef PG8_SCHED
}

__device__ __forceinline__ void grid_order(int L, int nM, int nN, int& pm, int& pn) {
  const int nwg = nM * nN;
  int wgid = L;
  { const int q = nwg / 8, r = nwg % 8, xcd = wgid % 8, off = wgid / 8; wgid = (xcd < r ? xcd * (q + 1) : r * (q + 1) + (xcd - r) * q) + off; }
  const int nig = 8 * nN, gid = wgid / nig, fm = gid * 8, gsz = (nM - fm) < 8 ? (nM - fm) : 8;
  pm = fm + ((wgid % nig) % gsz); pn = (wgid % nig) / gsz;
}

__device__ __forceinline__ void tile_decode(int t, int NT, int& mt, int& nt) {
  int g = t / (16 * NT), w = t % (16 * NT);
  mt = g * 16 + (w & 15);
  nt = w >> 4;
}

__device__ __forceinline__ void tr_tile(const float* __restrict__ src, int ld_src, int k0, int n0, bf16_t* __restrict__ dst,
                                        int ld_dst, int drow_base, int mode, float* tile) {
  const int tid = tidx();
#pragma unroll
  for (int i = 0; i < 4; ++i) {
    int k = (tid >> 4) + 16 * i, n4 = (tid & 15) * 4;
    const float* sp = src + (size_t)(k0 + k) * ld_src + n0 + n4;
    float4 v;
    v.x = __builtin_nontemporal_load(sp); v.y = __builtin_nontemporal_load(sp + 1); v.z = __builtin_nontemporal_load(sp + 2); v.w = __builtin_nontemporal_load(sp + 3);
    tile[k * 65 + n4 + 0] = v.x; tile[k * 65 + n4 + 1] = v.y; tile[k * 65 + n4 + 2] = v.z; tile[k * 65 + n4 + 3] = v.w;
  }
  __syncthreads();
  const int n = tid >> 2, kseg = (tid & 3) * 16;
  float o[16];
#pragma unroll
  for (int j = 0; j < 16; ++j) o[j] = tile[(kseg + j) * 65 + n];
  int drow;
  if (mode == 0) drow = drow_base + n;
  else {
    int gn = n0 + n;
    int isu = gn >= DFF;
    int j = isu ? gn - DFF : gn;
    drow = (j >> 7) * 256 + isu * 128 + (j & 127);
  }
  bf16_t* d = dst + (size_t)drow * ld_dst + k0 + kseg;
  *(uint4*)d = pack8(o);
  *(uint4*)(d + 8) = pack8(o + 8);
  __syncthreads();
}

__device__ void convert_layer(const Params& p, int l, char* smem, int vb0, int nvbk, int u_lo, int u_hi) {
  float* tile = (float*)smem;
  const int tid = tidx();
  const size_t wo = (size_t)(l & 1) * WSET;
  bf16_t* const W1T = p.W1T + wo; bf16_t* const WbT = p.WbT + wo; bf16_t* const WoT = p.WoT + wo; bf16_t* const WupT = p.WupT + wo; bf16_t* const WdT = p.WdT + wo;
  const int U_IN = 16 * 96, U_BR = 192, U_O = 256, U_UP = 16 * 88, U_DN = 44 * 16, U_FF = 64, U_PF = 64;
  const int total = U_IN + U_BR + U_O + U_UP + U_DN + U_FF + U_PF;
  const float* w_in = p.w_in + (size_t)l * DM * INW;
  const float* w_br = p.w_branch + (size_t)l * 4 * 256 * DM;
  if (u_hi > total) u_hi = total;
  for (int u = u_lo + vb0; u < u_hi; u += nvbk) {
    int v = u;
    if (v < U_IN) {
      int kt = v & 15, ntile = v >> 4;
      int dn0 = ntile * 64;
      int sn0 = dn0 < 1792 ? dn0 : dn0 + 256;
      tr_tile(w_in, INW, kt * 64, sn0, W1T, 1024, dn0, 0, tile);
      continue;
    }
    v -= U_IN;
    if (v < U_BR) {
      int i = v / 64, r = v % 64, kt = r & 3, ntile = r >> 2;
      tr_tile(w_br + (size_t)i * 256 * DM, DM, kt * 64, ntile * 64, WbT + (size_t)i * 1024 * 256, 256, ntile * 64, 0, tile);
      continue;
    }
    v -= U_BR;
    if (v < U_O) {
      int kt = v & 15, ntile = v >> 4;
      tr_tile(p.w_o + (size_t)l * DM * DM, DM, kt * 64, ntile * 64, WoT, 1024, ntile * 64, 0, tile);
      continue;
    }
    v -= U_O;
    if (v < U_UP) {
      int kt = v & 15, ntile = v >> 4;
      tr_tile(p.ffn_up + (size_t)l * DM * 2 * DFF, 2 * DFF, kt * 64, ntile * 64, WupT, 1024, 0, 1, tile);
      continue;
    }
    v -= U_UP;
    if (v < U_DN) {
      int kt = v % 44, ntile = v / 44;
      tr_tile(p.ffn_down + (size_t)l * DFF * DM, DM, kt * 64, ntile * 64, WdT, DFF, ntile * 64, 0, tile);
      continue;
    }
    v -= U_DN;
    if (v < U_FF) {
      int g = v >> 4, kb = v & 15;
      float* tw = tile + 64 * 65;
#pragma unroll
      for (int i = 0; i < 4; ++i) {
        int k = (tid >> 4) + 16 * i, n4 = (tid & 15) * 4;
        float4 vv = *(const float4*)(w_in + (size_t)(kb * 64 + k) * INW + 1792 + g * 64 + n4);
        tile[k * 65 + n4 + 0] = vv.x; tile[k * 65 + n4 + 1] = vv.y; tile[k * 65 + n4 + 2] = vv.z; tile[k * 65 + n4 + 3] = vv.w;
      }
      if (tid < 64) { tw[tid] = cospif(tid / 32.f); tw[64 + tid] = sinpif(tid / 32.f); }
      __syncthreads();
      int kk = tid & 63, kg = tid >> 6;
#pragma unroll 1
      for (int q = 0; q < 16; ++q) {
        int k2 = kg * 16 + q;
        float sc = 0.f, ss = 0.f;
#pragma unroll 4
        for (int cch = 0; cch < 64; ++cch) {
          float wv = tile[kk * 65 + cch];
          int m = (cch * k2) & 63;
          sc += wv * tw[m];
          ss += wv * tw[64 + m];
        }
        W1T[(size_t)(6144 + g * 64 + k2) * 1024 + kb * 64 + kk] = f2bf(sc);
        W1T[(size_t)(6144 + 256 + g * 64 + k2) * 1024 + kb * 64 + kk] = f2bf(ss);
      }
      __syncthreads();
      continue;
    }
    v -= U_FF;
    {
      int g = v >> 4, ob = v & 15;
      float* pw = tile;
      float* wb = tile + 64 * 65;
      const float* pws = p.pool_w + ((size_t)l * 4 + g) * 64 * 64;
      const float* psc = p.pool_scale + (size_t)l * 256 + g * 64;
      const float* wsrc = w_br + (size_t)3 * 256 * DM + (size_t)(g * 64) * DM + ob * 64;
#pragma unroll
      for (int i = 0; i < 4; ++i) {
        int r = (tid >> 4) + 16 * i, n4 = (tid & 15) * 4;
        float4 a = *(const float4*)(pws + r * 64 + n4);
        pw[r * 65 + n4 + 0] = a.x * psc[n4 + 0]; pw[r * 65 + n4 + 1] = a.y * psc[n4 + 1];
        pw[r * 65 + n4 + 2] = a.z * psc[n4 + 2]; pw[r * 65 + n4 + 3] = a.w * psc[n4 + 3];
        float4 b = *(const float4*)(wsrc + (size_t)r * DM + n4);
        wb[r * 65 + n4 + 0] = b.x; wb[r * 65 + n4 + 1] = b.y; wb[r * 65 + n4 + 2] = b.z; wb[r * 65 + n4 + 3] = b.w;
      }
      __syncthreads();
      int ii = tid & 63, og = tid >> 6;
#pragma unroll 1
      for (int q = 0; q < 16; ++q) {
        int oc = og * 16 + q;
        float s = 0.f;
#pragma unroll 4
        for (int o = 0; o < 64; ++o) s += pw[ii * 65 + o] * wb[o * 65 + oc];
        WbT[((size_t)3 * 1024 + ob * 64 + oc) * 256 + g * 64 + ii] = f2bf(s);
      }
      __syncthreads();
    }
  }
}

__device__ void build_tables(const Params& p, char* smem) {
  const int tid = tidx();
  const int U_TW = 4096, U_TC = 64, U_RP = 256, U_MOD = 384;
  const int total = U_TW + U_TC + U_RP + U_MOD;
  for (int u = vbid(); u < total; u += nvb()) {
    int v = u;
    if (v < U_TW) {
      size_t e0 = ((size_t)v * 256 + tid) * 8;
      int k1 = (int)(e0 >> 12), n0 = (int)(e0 & 4095);
      float o[8];
#pragma unroll
      for (int j = 0; j < 8; ++j) {
        int nn = n0 + j;
        int isn = nn >= 2048;
        int n = nn & 2047;
        int m = (k1 * n) & 2047;
        float fr = m * (1.f / 1024.f);
        o[j] = isn ? -sinpif(fr) : cospif(fr);
      }
      *(uint4*)(p.Tlat + e0) = pack8(o);
      continue;
    }
    v -= U_TW;
    if (v < U_TC) {
      size_t e0 = ((size_t)v * 256 + tid) * 8;
      int k1 = (int)(e0 >> 9), n0 = (int)(e0 & 511);
      float o[8];
#pragma unroll
      for (int j = 0; j < 8; ++j) {
        int nn = n0 + j;
        int isn = nn >= 256;
        int n = nn & 255;
        int m = (k1 * n) & 255;
        float fr = m * (1.f / 128.f);
        o[j] = isn ? -sinpif(fr) : cospif(fr);
      }
      *(uint4*)(p.Tctx + e0) = pack8(o);
      continue;
    }
    v -= U_TC;
    if (v < U_RP) {
      int e = v * 256 + tid;
      int n = e >> 5, i = e & 31;
      float freq = powf(10000.f, -(float)(i & 15) / 16.f);
      float pos = (i < 16) ? (float)(n >> 6) : (float)(n & 63);
      float ang = pos * freq;
      p.rope[n * 64 + i] = cosf(ang);
      p.rope[n * 64 + 32 + i] = sinf(ang);
      continue;
    }
    v -= U_RP;
    {
      int l = v / 96, cgp = v % 96;
      float* s = (float*)smem;
      float* red = s + 9 * 1024;
      for (int e = tid; e < 9 * 1024; e += 256) {
        float cv = (e < 8 * 1024) ? p.c[e] : p.c_ctx[e - 8 * 1024];
        s[e] = cv / (1.f + expf(-cv));
      }
      __syncthreads();
      int col = cgp * 64 + (tid & 63), kg = tid >> 6;
      float a[9];
#pragma unroll
      for (int r = 0; r < 9; ++r) a[r] = 0.f;
      const float* wm = p.w_mod + (size_t)l * DM * 6144 + col;
      for (int k0 = kg * 256; k0 < kg * 256 + 256; k0 += 16) {
        float wv[16];
#pragma unroll
        for (int j = 0; j < 16; ++j) wv[j] = wm[(size_t)(k0 + j) * 6144];
#pragma unroll
        for (int j = 0; j < 16; ++j)
#pragma unroll
          for (int r = 0; r < 9; ++r) a[r] += s[r * 1024 + k0 + j] * wv[j];
      }
#pragma unroll
      for (int r = 0; r < 9; ++r) red[(kg * 9 + r) * 64 + (tid & 63)] = a[r];
      __syncthreads();
      for (int o = tid; o < 9 * 64; o += 256) {
        int r = o >> 6, cc = o & 63;
        float sum = red[(0 * 9 + r) * 64 + cc] + red[(1 * 9 + r) * 64 + cc] + red[(2 * 9 + r) * 64 + cc] +
                    red[(3 * 9 + r) * 64 + cc];
        p.mod[((size_t)l * 9 + r) * 6144 + cgp * 64 + cc] = sum + p.b_mod[(size_t)l * 6144 + cgp * 64 + cc];
      }
      __syncthreads();
    }
  }
}

__device__ __forceinline__ float wave_sum(float v) {
#pragma unroll
  for (int o = 32; o >= 1; o >>= 1) v += __shfl_xor(v, o, 64);
  return v;
}

__device__ void rowpass(const Params& p, int l, int mode) {
  const int lane = tidx() & 63;
  const int gw = vbid() * 4 + (tidx() >> 6), nw = nvb() * 4;
  const bool ctx_on = (mode == 0) || (l < DEPTH - 1);
  const int nrows = ctx_on ? MTOT : MLAT;
  const bf16_t* raw = p.P;
  const float* ngbase = p.norm_g;
  const float* modbase = p.mod;
  bf16_t* hbase = p.H;
  asm volatile("" : "+s"(raw), "+s"(ngbase), "+s"(modbase), "+s"(hbase));
  const bool needh = !(mode == 2 && l == DEPTH - 1);
  const int lh = (mode == 2 && l + 1 < DEPTH) ? l + 1 : l;
  const bool first = (l == 0 && mode <= 1);
  const int R = (nrows + nw - 1) / nw;
  const int r_lo = gw * R, r_hi = (r_lo + R < nrows) ? r_lo + R : nrows;
  float ngA[16], ngB[16], gv[16], shv[16], scv[16];
  {
    const float* nga = ngbase + ((size_t)l * 4 + (mode == 1 ? 1 : 3)) * DM;
    const float* ngb = ngbase + ((size_t)lh * 4 + (mode == 1 ? 2 : 0)) * DM;
#pragma unroll
    for (int i = 0; i < 2; ++i)
#pragma unroll
      for (int hh = 0; hh < 2; ++hh) {
        const int o = lane * 8 + 512 * i + 4 * hh, e0 = 8 * i + 4 * hh;
        float4 a4 = *(const float4*)(nga + o);
        float4 b4 = *(const float4*)(ngb + o);
        ngA[e0] = a4.x; ngA[e0 + 1] = a4.y; ngA[e0 + 2] = a4.z; ngA[e0 + 3] = a4.w;
        ngB[e0] = b4.x; ngB[e0 + 1] = b4.y; ngB[e0 + 2] = b4.z; ngB[e0 + 3] = b4.w;
      }
  }
  int cur_m = -1;
  for (int row = r_lo; row < r_hi; ++row) {
    const bool isl = row < MLAT;
    const int mrow = isl ? (row >> 11) : 8;
    if (mrow != cur_m) {
      cur_m = mrow;
      const float* gt = modbase + (l * 9 + mrow) * 6144 + (mode == 1 ? 2048 : 5120);
      const float* mv = modbase + (lh * 9 + mrow) * 6144 + (mode == 1 ? 3072 : 0);
#pragma unroll
      for (int i = 0; i < 2; ++i)
#pragma unroll
        for (int hh = 0; hh < 2; ++hh) {
          const int o = lane * 8 + 512 * i + 4 * hh, e0 = 8 * i + 4 * hh;
          float4 g4 = *(const float4*)(gt + o);
          float4 s4 = *(const float4*)(mv + o);
          float4 c4 = *(const float4*)(mv + 1024 + o);
          gv[e0] = g4.x; gv[e0 + 1] = g4.y; gv[e0 + 2] = g4.z; gv[e0 + 3] = g4.w;
          shv[e0] = s4.x; shv[e0 + 1] = s4.y; shv[e0 + 2] = s4.z; shv[e0 + 3] = s4.w;
          scv[e0] = c4.x; scv[e0 + 1] = c4.y; scv[e0 + 2] = c4.z; scv[e0 + 3] = c4.w;
        }
    }
    const float* xin;
    float* xout;
    if (isl) {
      size_t o = (size_t)row * DM;
      xin = (first ? p.x : p.out) + o;
      xout = p.out + o;
    } else {
      size_t o = (size_t)(row - MLAT) * DM;
      xin = (first ? p.ctx : p.xc) + o;
      xout = p.xc + o;
    }
    float xv[16], rv[16];
#pragma unroll
    for (int i = 0; i < 2; ++i)
#pragma unroll
      for (int hh = 0; hh < 2; ++hh) {
        const int o = lane * 8 + 512 * i + 4 * hh, e0 = 8 * i + 4 * hh;
        float4 t0 = *(const float4*)(xin + o);
        xv[e0] = t0.x; xv[e0 + 1] = t0.y; xv[e0 + 2] = t0.z; xv[e0 + 3] = t0.w;
      }
    if (mode != 0) {
#pragma unroll
      for (int i = 0; i < 2; ++i) unpack8(*(const uint4*)(raw + (size_t)row * DM + lane * 8 + 512 * i), &rv[8 * i]);
      float ss = 0.f;
#pragma unroll
      for (int e = 0; e < 16; ++e) ss += rv[e] * rv[e];
      ss = wave_sum(ss);
      const float rstd = rsqrtf(ss * (1.f / DM) + EPSV);
#pragma unroll
      for (int e = 0; e < 16; ++e) xv[e] += gv[e] * (rv[e] * rstd * ngA[e]);
    }
    uint4 hq[2];
    if (needh) {
      float ss = 0.f;
#pragma unroll
      for (int e = 0; e < 16; ++e) ss += xv[e] * xv[e];
      ss = wave_sum(ss);
      const float rstd = rsqrtf(ss * (1.f / DM) + EPSV);
#pragma unroll
      for (int i = 0; i < 2; ++i) {
        float hv[8];
#pragma unroll
        for (int e = 0; e < 8; ++e) hv[e] = xv[8 * i + e] * rstd * ngB[8 * i + e] * (1.f + scv[8 * i + e]) + shv[8 * i + e];
        hq[i] = pack8(hv);
      }
    }
    if (mode != 0) {
#pragma unroll
      for (int i = 0; i < 2; ++i)
#pragma unroll
        for (int hh = 0; hh < 2; ++hh) {
          const int e0 = 8 * i + 4 * hh;
          float4 o4; o4.x = xv[e0]; o4.y = xv[e0 + 1]; o4.z = xv[e0 + 2]; o4.w = xv[e0 + 3];
          *(float4*)(xout + lane * 8 + 512 * i + 4 * hh) = o4;
        }
    }
    if (needh) {
      bf16_t* hr = hbase + (size_t)row * DM;
#pragma unroll
      for (int i = 0; i < 2; ++i) *(uint4*)(hr + lane * 8 + 512 * i) = hq[i];
    }
  }
}

struct SchedG1 {
  const char* H; const char* W; int nMt, nreg, total, G, c;
  __device__ __forceinline__ bool next(int i, Unit& u) const {
    const int L = i * G + c;
    if (L >= total) return false;
    if (L < nreg) { grid_order(L, nMt, 24, u.pm, u.pn); u.kind = 0; }
    else if (L < nreg + 2 * nMt) { const int v = L - nreg; u.pm = v & 1; u.pn = v >> 1; u.kind = 1; }
    else { const int v = L - nreg - 2 * nMt; u.pm = 64 + (v & 7); u.pn = 1 + (v >> 3); u.kind = 0; }
    return true;
  }
  __device__ __forceinline__ const char* aptr(const Unit& u) const {
    return u.kind == 0 ? H + (size_t)u.pm * 256 * 2048 : W + (size_t)(6144 + u.pm * 256) * 2048;
  }
  __device__ __forceinline__ const char* bptr(const Unit& u) const {
    return u.kind == 0 ? W + (size_t)u.pn * 256 * 2048 : H + (size_t)u.pn * 256 * 2048;
  }
};
struct EpiG1 {
  static constexpr bool PERM = true;
  bf16_t* P; bf16_t* FTlat; bf16_t* FTctx; uint4* GT;
  __device__ __forceinline__ bool operator()(f32x4 (&acc)[2][2][4][2], const Unit& u, int wr, int wc, int fr, int fq) const {
#pragma unroll
    for (int ai = 0; ai < 2; ++ai)
#pragma unroll
      for (int bj = 0; bj < 2; ++bj)
#pragma unroll
        for (int m = 0; m < 4; ++m) {
          const int r = 256 * u.pm + 128 * ai + 64 * wr + 16 * m + fr;
          const int cc = 256 * u.pn + 128 * bj + 32 * wc + 8 * fq;
          f32x4 v0 = acc[ai][bj][m][0], v1 = acc[ai][bj][m][1];
          uint4 pk;
          if (u.kind == 0) {
            if (u.pn >= 8) {
              pk.x = pack2(1.f + __expf(-v0[0]), 1.f + __expf(-v0[1])); pk.y = pack2(1.f + __expf(-v0[2]), 1.f + __expf(-v0[3]));
              pk.z = pack2(1.f + __expf(-v1[0]), 1.f + __expf(-v1[1])); pk.w = pack2(1.f + __expf(-v1[2]), 1.f + __expf(-v1[3]));
              const int tb = 16 * u.pm + 8 * ai + 4 * wr + m;
              const int cb = 8 * (u.pn - 8) + 4 * bj + wc;
              GT[((size_t)tb * 128 + cb) * 64 + fq * 16 + fr] = pk;
            } else {
              pk.x = pack2(v0[0], v0[1]); pk.y = pack2(v0[2], v0[3]); pk.z = pack2(v1[0], v1[1]); pk.w = pack2(v1[2], v1[3]);
              *(uint4*)(P + (size_t)r * PW + cc) = pk;
            }
          } else {
            const int cs = r >> 8, col = r & 255;
            pk.x = pack2(v0[0], v0[1]); pk.y = pack2(v0[2], v0[3]); pk.z = pack2(v1[0], v1[1]); pk.w = pack2(v1[2], v1[3]);
            if (cc < MLAT) {
              const int bb = cc >> 11, nn = cc & 2047;
              *(uint4*)(FTlat + (((size_t)col * 8 + bb) * 2 + cs) * 2048 + nn) = pk;
            } else {
              const int tk = cc - MLAT;
              const int bb = tk >> 8, nn = tk & 255;
              *(uint4*)(FTctx + (((size_t)col * 8 + bb) * 2 + cs) * 256 + nn) = pk;
            }
          }
        }
    return true;
  }
};
__device__ void phase_gemm1(const Params& p, int l, char* smem) {
  const bool lastl = (l == DEPTH - 1);
  SchedG1 S;
  S.H = (const char*)p.H; S.W = (const char*)(p.W1T + (size_t)(l & 1) * WSET);
  S.nMt = lastl ? 64 : 72;
  S.nreg = S.nMt * 24;
  S.total = S.nreg + 2 * S.nMt + (lastl ? 16 : 0);
  S.G = gridDim.x; S.c = blockIdx.x;
  EpiG1 E{p.P, p.FTlat, p.FTctx, p.GT};
  gemm_phase((PG8_LAS unsigned char*)smem, 1024, 1024, 1024, S, E);
}

struct SchedDFT {
  const char* T; const char* FT; int G, c;
  __device__ __forceinline__ bool next(int i, Unit& u) const {
    const int L = i * G + c;
    if (L >= 256) return false;
    u.kind = L >> 5; u.pm = (L >> 2) & 7; u.pn = L & 3;
    return true;
  }
  __device__ __forceinline__ const char* aptr(const Unit& u) const { return T + ((size_t)u.pm * 256 * 4096 + u.pn * 1024) * 2; }
  __device__ __forceinline__ const char* bptr(const Unit& u) const { return FT + ((size_t)u.kind * 4096 + u.pn * 1024) * 2; }
};
struct SchedDFTc {
  const char* T; const char* FT; int G, c;
  __device__ __forceinline__ bool next(int i, Unit& u) const {
    const int L = i * G + (G - 1 - c);
    if (L >= 8) return false;
    u.kind = L; u.pm = 0; u.pn = 0;
    return true;
  }
  __device__ __forceinline__ const char* aptr(const Unit& u) const { return T; }
  __device__ __forceinline__ const char* bptr(const Unit& u) const { return FT + (size_t)u.kind * 512 * 2; }
};
struct EpiDFT {
  static constexpr bool PERM = true;
  uint4* DP; int ctx;
  __device__ __forceinline__ bool operator()(f32x4 (&acc)[2][2][4][2], const Unit& u, int wr, int wc, int fr, int fq) const {
#pragma unroll
    for (int ai = 0; ai < 2; ++ai)
#pragma unroll
      for (int bj = 0; bj < 2; ++bj)
#pragma unroll
        for (int m = 0; m < 4; ++m) {
          const int tb = ctx ? (u.kind * 16 + 8 * ai + 4 * wr + m) : (u.kind * 128 + 16 * u.pm + 8 * ai + 4 * wr + m);
          const int cb = 4 * bj + wc;
          const size_t base = ctx ? (size_t)4 * 1024 * 8 * 64 : (size_t)u.pn * 1024 * 8 * 64;
          const f32x4 v0 = acc[ai][bj][m][0], v1 = acc[ai][bj][m][1];
          uint4 pk;
          pk.x = pack2(v0[0], v0[1]); pk.y = pack2(v0[2], v0[3]); pk.z = pack2(v1[0], v1[1]); pk.w = pack2(v1[2], v1[3]);
          DP[base + ((size_t)tb * 8 + cb) * 64 + fq * 16 + fr] = pk;
        }
    return true;
  }
};
__device__ __forceinline__ void dft_sum_pair(const Params& p, int chunk0, int chunk1, bool has1) {
  const int tid = tidx();
  const uint4* DP = (const uint4*)p.H;
  const int lane = tid & 63, fr = lane & 15, fq = lane >> 4;
  uint4 v[2][4];
  int token[2], col[2], npart[2];
#pragma unroll
  for (int j = 0; j < 2; ++j) {
    const int chunk = (j == 0) ? chunk0 : (has1 ? chunk1 : chunk0);
    if (chunk < 2048) {
      const int pidx = chunk * 4 + (tid >> 6);
      const int tb = pidx >> 3, cb = pidx & 7;
#pragma unroll
      for (int ks = 0; ks < 4; ++ks) v[j][ks] = DP[(size_t)ks * 1024 * 8 * 64 + (size_t)pidx * 64 + lane];
      token[j] = tb * 16 + fr; col[j] = cb * 32 + fq * 8; npart[j] = 4;
    } else {
      const int pidx = (chunk - 2048) * 4 + (tid >> 6);
      const int tb = pidx >> 3, cb = pidx & 7;
      v[j][0] = DP[(size_t)4 * 1024 * 8 * 64 + (size_t)pidx * 64 + lane];
      v[j][1] = v[j][0]; v[j][2] = v[j][0]; v[j][3] = v[j][0];
      token[j] = MLAT + tb * 16 + fr; col[j] = cb * 32 + fq * 8; npart[j] = 1;
    }
  }
#pragma unroll
  for (int j = 0; j < 2; ++j) {
    if (j == 1 && !has1) break;
    float a[8], t[8];
    unpack8(v[j][0], a);
    if (npart[j] == 4) {
#pragma unroll
      for (int ks = 1; ks < 4; ++ks) {
        unpack8(v[j][ks], t);
#pragma unroll
        for (int e = 0; e < 8; ++e) a[e] += t[e];
      }
    }
    const float sc = (npart[j] == 4) ? 0.00276213586400995f : 0.0078125f;
#pragma unroll
    for (int e = 0; e < 8; ++e) a[e] *= sc;
    *(uint4*)(p.BR + (size_t)token[j] * 1024 + 512 + col[j]) = pack8(a);
  }
}

struct SchedBr {
  const char* BR; const char* Wb; int ntiles, nM, G, c;
  __device__ __forceinline__ bool next(int i, Unit& u) const {
    const int L = (i >> 2) * G + c;
    if (L >= ntiles) return false;
    grid_order(L, nM, 4, u.pm, u.pn); u.kind = i & 3;
    return true;
  }
  __device__ __forceinline__ const char* aptr(const Unit& u) const { return BR + ((size_t)u.pm * 256 * 1024 + u.kind * 256) * 2; }
  __device__ __forceinline__ const char* bptr(const Unit& u) const { return Wb + ((size_t)(u.kind * 1024 + u.pn * 256) * 256) * 2; }
};
struct EpiBr {
  static constexpr bool PERM = true;
  const uint4* __restrict__ GT; bf16_t* __restrict__ H;
  __device__ __forceinline__ bool operator()(f32x4 (&acc)[2][2][4][2], const Unit& u, int wr, int wc, int fr, int fq) const {
    const int seg = u.kind;
    const bool lastseg = (seg == 3);
    int lanei = fq * 16 + fr;
    asm volatile("" : "+v"(lanei));
    const uint4* __restrict__ gbase = GT + ((size_t)(16 * u.pm + 4 * wr) * 128 + seg * 32 + 8 * u.pn + wc) * 64 + lanei;
    const size_t nxt = lastseg ? 0 : (size_t)32 * 64;
    const float keep = lastseg ? 0.f : 1.f;
    uint4 g[2][4], gn[2][4];
#pragma unroll
    for (int m = 0; m < 4; ++m) {
      const uint4* gp = gbase + (size_t)m * 128 * 64;
      g[0][m] = gp[0];
      gn[0][m] = gp[nxt];
    }
#pragma unroll
    for (int c = 0; c < 4; ++c) {
      const int ai = c >> 1, bj = c & 1;
      if (c + 1 < 4) {
        const int ai2 = (c + 1) >> 1, bj2 = (c + 1) & 1;
#pragma unroll
        for (int m = 0; m < 4; ++m) {
          const uint4* gp = gbase + ((size_t)(8 * ai2 + m) * 128 + 4 * bj2) * 64;
          g[(c + 1) & 1][m] = gp[0];
          gn[(c + 1) & 1][m] = gp[nxt];
        }
      }
#pragma unroll
      for (int m = 0; m < 4; ++m) {
        float f[8], fn[8], v[8];
        unpack8(g[c & 1][m], f);
        unpack8(gn[c & 1][m], fn);
#pragma unroll
        for (int e = 0; e < 8; ++e) {
          float ff = __builtin_amdgcn_rcpf(f[e]);
          if (!lastseg) ff *= fn[e];
          v[e] = acc[ai][bj][m][e >> 2][e & 3] * ff;
        }
        if (lastseg) {
          const int r = 256 * u.pm + 128 * ai + 64 * wr + 16 * m + fr;
          const int cc = 256 * u.pn + 128 * bj + 32 * wc + 8 * fq;
          *(uint4*)(H + (size_t)r * 1024 + cc) = pack8(v);
        }
#pragma unroll
        for (int e = 0; e < 8; ++e) acc[ai][bj][m][e >> 2][e & 3] = v[e] * keep;
      }
    }
    return false;
  }
};
__device__ void phase_branch(const Params& p, int l, char* smem) {
  SchedBr S;
  S.BR = (const char*)p.BR; S.Wb = (const char*)(p.WbT + (size_t)(l & 1) * WSET);
  S.nM = (l == DEPTH - 1) ? 64 : 72; S.ntiles = S.nM * 4; S.G = gridDim.x; S.c = blockIdx.x;
  EpiBr E{p.GT, p.H};
  int Kb = 256;
  asm volatile("" : "+s"(Kb));
  gemm_phase((PG8_LAS unsigned char*)smem, Kb, 1024, 256, S, E);
}

struct SchedGrid {
  const char* X; const char* W; int nM, nN, G, c; size_t tstep;
  __device__ __forceinline__ bool next(int i, Unit& u) const {
    const int L = i * G + c;
    if (L >= nM * nN) return false;
    grid_order(L, nM, nN, u.pm, u.pn); u.kind = 0;
    return true;
  }
  __device__ __forceinline__ const char* aptr(const Unit& u) const { return X + (size_t)u.pm * tstep; }
  __device__ __forceinline__ const char* bptr(const Unit& u) const { return W + (size_t)u.pn * tstep; }
};
struct EpiRaw {
  static constexpr bool PERM = true;
  bf16_t* raw;
  __device__ __forceinline__ bool operator()(f32x4 (&acc)[2][2][4][2], const Unit& u, int wr, int wc, int fr, int fq) const {
#pragma unroll
    for (int ai = 0; ai < 2; ++ai)
#pragma unroll
      for (int bj = 0; bj < 2; ++bj)
#pragma unroll
        for (int m = 0; m < 4; ++m) {
          const int r = 256 * u.pm + 128 * ai + 64 * wr + 16 * m + fr;
          const int cc = 256 * u.pn + 128 * bj + 32 * wc + 8 * fq;
          const f32x4 v0 = acc[ai][bj][m][0], v1 = acc[ai][bj][m][1];
          uint4 pk;
          pk.x = pack2(v0[0], v0[1]); pk.y = pack2(v0[2], v0[3]); pk.z = pack2(v1[0], v1[1]); pk.w = pack2(v1[2], v1[3]);
          *(uint4*)(raw + (size_t)r * 1024 + cc) = pk;
        }
    return true;
  }
};
struct EpiSwiglu {
  static constexpr bool PERM = true;
  bf16_t* act;
  __device__ __forceinline__ bool operator()(f32x4 (&acc)[2][2][4][2], const Unit& u, int wr, int wc, int fr, int fq) const {
#pragma unroll
    for (int ai = 0; ai < 2; ++ai)
#pragma unroll
      for (int m = 0; m < 4; ++m) {
        const int r = 256 * u.pm + 128 * ai + 64 * wr + 16 * m + fr;
        const int fcol = 128 * u.pn + 32 * wc + 8 * fq;
        float o[8];
#pragma unroll
        for (int n = 0; n < 2; ++n)
#pragma unroll
          for (int j = 0; j < 4; ++j) o[4 * n + j] = silu_(acc[ai][0][m][n][j]) * acc[ai][1][m][n][j];
        *(uint4*)(act + (size_t)r * DFF + fcol) = pack8(o);
      }
    return true;
  }
};

__device__ void phase_proj(const Params& p, int l, int mode, char* smem) {
  const int K = mode == 0 ? 1024 : DFF;
  SchedGrid S;
  S.X = mode == 0 ? (const char*)p.H : (const char*)(p.P + ACT_OFF);
  S.W = mode == 0 ? (const char*)(p.WoT + (size_t)(l & 1) * WSET) : (const char*)(p.WdT + (size_t)(l & 1) * WSET);
  S.nM = (l == DEPTH - 1) ? 64 : 72; S.nN = 4; S.G = gridDim.x; S.c = blockIdx.x; S.tstep = (size_t)256 * K * 2;
  EpiRaw E{p.P};
  gemm_phase((PG8_LAS unsigned char*)smem, K, K, K, S, E);
}
__device__ void phase_up(const Params& p, int l, char* smem) {
  SchedGrid S;
  S.X = (const char*)p.H; S.W = (const char*)(p.WupT + (size_t)(l & 1) * WSET);
  S.nM = (l == DEPTH - 1) ? 64 : 72; S.nN = 22; S.G = gridDim.x; S.c = blockIdx.x; S.tstep = (size_t)256 * 1024 * 2;
  EpiSwiglu E{p.P + ACT_OFF};
  gemm_phase((PG8_LAS unsigned char*)smem, 1024, 1024, 1024, S, E);
}

__device__ __forceinline__ void item_decode(int it, int& s, int& b, int& h, int& c, int& rowbase, int& pos0) {
  if (it < 512) { s = 0; b = it >> 6; h = (it >> 4) & 3; c = it & 15; rowbase = b * 2048 + c * 128; pos0 = c * 128; }
  else { int v = it - 512; s = 1; b = v >> 3; h = (v >> 1) & 3; c = v & 1; rowbase = MLAT + b * 256 + c * 128; pos0 = 0; }
}
__device__ __forceinline__ float log_sigmoid_(float x) { return -log1pf(expf(-x)); }

__device__ __forceinline__ void load_half(const bf16_t* g, float (&xv)[32]) {
#pragma unroll
  for (int q = 0; q < 4; ++q) unpack8(*(const uint4*)(g + q * 8), &xv[q * 8]);
}
__device__ __forceinline__ void rope_half(float (&xv)[32], const float* tab  ) {
#pragma unroll
  for (int q = 0; q < 4; ++q) {
    float4 c4 = *(const float4*)(tab + q * 4);
    float4 s4 = *(const float4*)(tab + 32 + q * 4);
    float cc[4] = {c4.x, c4.y, c4.z, c4.w}, sn[4] = {s4.x, s4.y, s4.z, s4.w};
#pragma unroll
    for (int e = 0; e < 4; ++e) {
      int i = q * 4 + e;
      float x1 = xv[i], x2 = xv[i + 16];
      xv[i] = x1 * cc[e] - x2 * sn[e];
      xv[i + 16] = x1 * sn[e] + x2 * cc[e];
    }
  }
}

__device__ __forceinline__ void ret_kv_item(const Params& p, int l, int it, char* smem) {
  const int tid = tidx(), lane = tid & 63, w = tid >> 6, lr = lane & 15, lq = lane >> 4;
  int s, b, h, c, rowbase, pos0;
  item_decode(it, s, b, h, c, rowbase, pos0);
  const float lgf = log_sigmoid_(p.ret_decay[(l * 2 + 0) * 4 + h]);
  const float lgb = log_sigmoid_(p.ret_decay[(l * 2 + 1) * 4 + h]);
  bf16_t* AT = (bf16_t*)smem;
  bf16_t* VT = AT + 128 * 136;
  {
    const int j = tid >> 1, half = tid & 1;
    const bf16_t* prow = p.P + (size_t)(rowbase + j) * PW;
    float kv[32];
    load_half(prow + 256 + h * 64 + half * 32, kv);
    if (s == 0) rope_half(kv, p.rope + (size_t)(pos0 + j) * 64 + half * 16);
    float df = expf(lgf * (float)(127 - j)), db = expf(lgb * (float)j);
#pragma unroll
    for (int e = 0; e < 32; ++e) {
      int d = half * 32 + e;
      AT[d * 136 + j] = f2bf(kv[e] * df);
      AT[(64 + d) * 136 + j] = f2bf(kv[e] * db);
    }
    const bf16_t* vsrc = prow + 512 + h * 64 + half * 32;
#pragma unroll
    for (int q = 0; q < 4; ++q) {
      uint4 vv = *(const uint4*)(vsrc + q * 8);
      unsigned uu[4] = {vv.x, vv.y, vv.z, vv.w};
#pragma unroll
      for (int e = 0; e < 4; ++e) {
        int d = half * 32 + q * 8 + e * 2;
        VT[d * 136 + j] = (bf16_t)(uu[e] & 0xffffu);
        VT[(d + 1) * 136 + j] = (bf16_t)(uu[e] >> 16);
      }
    }
  }
  __syncthreads();
  f32x4 acc[2][4];
#pragma unroll
  for (int mi = 0; mi < 2; ++mi)
#pragma unroll
    for (int ni = 0; ni < 4; ++ni) acc[mi][ni] = f32x4{0.f, 0.f, 0.f, 0.f};
#pragma unroll
  for (int ks = 0; ks < 4; ++ks) {
    bf16x8 af[2], bfr[4];
#pragma unroll
    for (int mi = 0; mi < 2; ++mi) af[mi] = *(const bf16x8*)(AT + (w * 32 + mi * 16 + lr) * 136 + ks * 32 + lq * 8);
#pragma unroll
    for (int ni = 0; ni < 4; ++ni) bfr[ni] = *(const bf16x8*)(VT + (ni * 16 + lr) * 136 + ks * 32 + lq * 8);
#pragma unroll
    for (int mi = 0; mi < 2; ++mi)
#pragma unroll
      for (int ni = 0; ni < 4; ++ni)
        acc[mi][ni] = __builtin_amdgcn_mfma_f32_16x16x32_bf16(af[mi], bfr[ni], acc[mi][ni], 0, 0, 0);
  }
  float* kvout = p.KV + (size_t)it * 2 * 4096;
#pragma unroll
  for (int mi = 0; mi < 2; ++mi)
#pragma unroll
    for (int ni = 0; ni < 4; ++ni) {
      int r = w * 32 + mi * 16 + lq * 4;
      int dir = r >> 6, d = r & 63;
      int v = ni * 16 + lr;
      float4 o;
      o.x = acc[mi][ni][0]; o.y = acc[mi][ni][1]; o.z = acc[mi][ni][2]; o.w = acc[mi][ni][3];
      *(float4*)(kvout + (size_t)dir * 4096 + v * 64 + d) = o;
    }
  __syncthreads();
}

__device__ void ret_scan(const Params& p, int l) {
  const int total = NBATCH * 4 * 2 * 4096;
  for (int e = vbid() * 256 + tidx(); e < total; e += nvb() * 256) {
    int vd = e & 4095, dir = (e >> 12) & 1, h = (e >> 13) & 3, b = e >> 15;
    float lg = log_sigmoid_(p.ret_decay[(l * 2 + dir) * 4 + h]);
    float cd = expf(lg * 128.f);
    float S = 0.f;
    for (int st = 0; st < 18; ++st) {
      int it;
      if (dir == 0) it = (st < 2) ? 512 + ((b * 4 + h) * 2 + st) : ((b * 4 + h) * 16 + (st - 2));
      else it = (st < 2) ? 512 + ((b * 4 + h) * 2 + (1 - st)) : ((b * 4 + h) * 16 + (17 - st));
      size_t o = ((size_t)it * 2 + dir) * 4096 + vd;
      p.ST[o] = f2bf(S);
      S = S * cd + p.KV[o];
    }
  }
}

__device__ __forceinline__ void ret_out_item(const Params& p, int l, int it, char* smem) {
  const int tid = tidx(), lane = tid & 63, w = tid >> 6, lr = lane & 15, lq = lane >> 4;
  int s, b, h, c, rowbase, pos0;
  item_decode(it, s, b, h, c, rowbase, pos0);
  const float lgf = log_sigmoid_(p.ret_decay[(l * 2 + 0) * 4 + h]);
  const float lgb = log_sigmoid_(p.ret_decay[(l * 2 + 1) * 4 + h]);
  bf16_t* Qs = (bf16_t*)smem;
  bf16_t* Ks = Qs + 128 * 72;
  bf16_t* Ps = (bf16_t*)smem;
  bf16_t* VT = (bf16_t*)(smem + 36864);
  bf16_t* Ss = (bf16_t*)(smem + 54272);
  {
    const int j = tid >> 1, half = tid & 1;
    const bf16_t* prow = p.P + (size_t)(rowbase + j) * PW;
    const float* tab = p.rope + (size_t)(pos0 + j) * 64 + half * 16;
    float xv[32];
    load_half(prow + h * 64 + half * 32, xv);
    if (s == 0) rope_half(xv, tab);
#pragma unroll
    for (int e = 0; e < 32; ++e) xv[e] *= 0.125f;
#pragma unroll
    for (int q = 0; q < 4; ++q) *(uint4*)(Qs + j * 72 + half * 32 + q * 8) = pack8(&xv[q * 8]);
    load_half(prow + 256 + h * 64 + half * 32, xv);
    if (s == 0) rope_half(xv, tab);
#pragma unroll
    for (int q = 0; q < 4; ++q) *(uint4*)(Ks + j * 72 + half * 32 + q * 8) = pack8(&xv[q * 8]);
    const bf16_t* vsrc = prow + 512 + h * 64 + half * 32;
#pragma unroll
    for (int q = 0; q < 4; ++q) {
      uint4 vv = *(const uint4*)(vsrc + q * 8);
      unsigned uu[4] = {vv.x, vv.y, vv.z, vv.w};
#pragma unroll
      for (int e = 0; e < 4; ++e) {
        int d = half * 32 + q * 8 + e * 2;
        VT[d * 136 + j] = (bf16_t)(uu[e] & 0xffffu);
        VT[(d + 1) * 136 + j] = (bf16_t)(uu[e] >> 16);
      }
    }
    const bf16_t* st = p.ST + (size_t)it * 2 * 4096;
#pragma unroll
    for (int q = 0; q < 4; ++q) {
      int ch = tid + 256 * q;
      int rowi = ch >> 3, cc = ch & 7;
      *(uint4*)(Ss + rowi * 72 + cc * 8) = *(const uint4*)(st + (size_t)rowi * 64 + cc * 8);
    }
  }
  __syncthreads();
  const int i0 = w * 32;
  uint4 gq[4];
  {
    const bf16_t* gp0 = p.P + (size_t)(rowbase + i0 + (lane >> 1)) * PW + 768 + h * 64 + (lane & 1) * 32;
#pragma unroll
    for (int q = 0; q < 4; ++q) gq[q] = *(const uint4*)(gp0 + q * 8);
  }
  bf16x8 qf[2][2];
#pragma unroll
  for (int mi = 0; mi < 2; ++mi)
#pragma unroll
    for (int ks = 0; ks < 2; ++ks) qf[mi][ks] = *(const bf16x8*)(Qs + (i0 + mi * 16 + lr) * 72 + ks * 32 + lq * 8);
  f32x4 sacc[2][8];
#pragma unroll
  for (int mi = 0; mi < 2; ++mi)
#pragma unroll
    for (int nj = 0; nj < 8; ++nj) sacc[mi][nj] = f32x4{0.f, 0.f, 0.f, 0.f};
#pragma unroll
  for (int nj = 0; nj < 8; ++nj)
#pragma unroll
    for (int ks = 0; ks < 2; ++ks) {
      bf16x8 kf = *(const bf16x8*)(Ks + (nj * 16 + lr) * 72 + ks * 32 + lq * 8);
#pragma unroll
      for (int mi = 0; mi < 2; ++mi) sacc[mi][nj] = __builtin_amdgcn_mfma_f32_16x16x32_bf16(qf[mi][ks], kf, sacc[mi][nj], 0, 0, 0);
    }
  __syncthreads();
#pragma unroll
  for (int mi = 0; mi < 2; ++mi)
#pragma unroll
    for (int nj = 0; nj < 8; ++nj)
#pragma unroll
      for (int r = 0; r < 4; ++r) {
        int i = i0 + mi * 16 + lq * 4 + r, j = nj * 16 + lr;
        float dd = (i >= j) ? __expf(lgf * (float)(i - j)) : __expf(lgb * (float)(j - i));
        Ps[i * 136 + j] = f2bf(sacc[mi][nj][r] * dd);
      }
  __syncthreads();
  f32x4 accF[2][4], accB[2][4], acc1[2][4];
#pragma unroll
  for (int mi = 0; mi < 2; ++mi)
#pragma unroll
    for (int nv = 0; nv < 4; ++nv) {
      accF[mi][nv] = f32x4{0.f, 0.f, 0.f, 0.f};
      accB[mi][nv] = f32x4{0.f, 0.f, 0.f, 0.f};
      acc1[mi][nv] = f32x4{0.f, 0.f, 0.f, 0.f};
    }
#pragma unroll
  for (int nv = 0; nv < 4; ++nv)
#pragma unroll
    for (int ks = 0; ks < 2; ++ks) {
      bf16x8 sf = *(const bf16x8*)(Ss + (nv * 16 + lr) * 72 + ks * 32 + lq * 8);
      bf16x8 sb = *(const bf16x8*)(Ss + (64 + nv * 16 + lr) * 72 + ks * 32 + lq * 8);
#pragma unroll
      for (int mi = 0; mi < 2; ++mi) {
        accF[mi][nv] = __builtin_amdgcn_mfma_f32_16x16x32_bf16(qf[mi][ks], sf, accF[mi][nv], 0, 0, 0);
        accB[mi][nv] = __builtin_amdgcn_mfma_f32_16x16x32_bf16(qf[mi][ks], sb, accB[mi][nv], 0, 0, 0);
      }
    }
#pragma unroll
  for (int ks = 0; ks < 4; ++ks) {
    bf16x8 pf[2], vf[4];
#pragma unroll
    for (int mi = 0; mi < 2; ++mi) pf[mi] = *(const bf16x8*)(Ps + (i0 + mi * 16 + lr) * 136 + ks * 32 + lq * 8);
#pragma unroll
    for (int nv = 0; nv < 4; ++nv) vf[nv] = *(const bf16x8*)(VT + (nv * 16 + lr) * 136 + ks * 32 + lq * 8);
#pragma unroll
    for (int mi = 0; mi < 2; ++mi)
#pragma unroll
      for (int nv = 0; nv < 4; ++nv) acc1[mi][nv] = __builtin_amdgcn_mfma_f32_16x16x32_bf16(pf[mi], vf[nv], acc1[mi][nv], 0, 0, 0);
  }
#pragma unroll
  for (int mi = 0; mi < 2; ++mi)
#pragma unroll
    for (int r = 0; r < 4; ++r) {
      int i = i0 + mi * 16 + lq * 4 + r;
      float qd = __expf(lgf * (float)(i + 1)), qb = __expf(lgb * (float)(128 - i));
      float* yr = (float*)(smem + i * 272);
#pragma unroll
      for (int nv = 0; nv < 4; ++nv) yr[nv * 16 + lr] = acc1[mi][nv][r] + qd * accF[mi][nv][r] + qb * accB[mi][nv][r];
    }
  __syncthreads();
  {
    const int i = i0 + (lane >> 1), half = lane & 1;
    const float* yr = (const float*)(smem + i * 272) + half * 32;
    float y[32];
#pragma unroll
    for (int q = 0; q < 8; ++q) {
      float4 t4 = *(const float4*)(yr + q * 4);
      y[q * 4 + 0] = t4.x; y[q * 4 + 1] = t4.y; y[q * 4 + 2] = t4.z; y[q * 4 + 3] = t4.w;
    }
    float sum = 0.f;
#pragma unroll
    for (int e = 0; e < 32; ++e) sum += y[e];
    sum += __shfl_xor(sum, 1, 64);
    float mu = sum * (1.f / 64.f);
    float vs = 0.f;
#pragma unroll
    for (int e = 0; e < 32; ++e) { y[e] -= mu; vs += y[e] * y[e]; }
    vs += __shfl_xor(vs, 1, 64);
    float rstd = rsqrtf(vs * (1.f / 64.f) + EPSV);
    size_t row = (size_t)(rowbase + i);
    bf16_t* op = p.BR + row * 1024 + h * 64 + half * 32;
#pragma unroll
    for (int q = 0; q < 4; ++q) {
      float g8[8], o8[8];
      unpack8(gq[q], g8);
#pragma unroll
      for (int e = 0; e < 8; ++e) o8[e] = y[q * 8 + e] * rstd * silu_(g8[e]);
      *(uint4*)(op + q * 8) = pack8(o8);
    }
  }
  __syncthreads();
}

__device__ __forceinline__ void convpool_unit(const Params& p, int l, int u) {
  const int tid = tidx();
  const int row0 = u * 8;
  int seqstart, len;
  if (row0 < MLAT) { seqstart = (row0 >> 11) << 11; len = SEQ; }
  else { seqstart = MLAT + (((row0 - MLAT) >> 8) << 8); len = CTXL; }
  const float* cw = p.conv_w + (size_t)l * 3 * 256;
  for (int itx = 0; itx < 1; ++itx) {
    int idx = tid + 256 * itx;
    int tok = idx >> 5, cgp = idx & 31, ch = cgp * 8;
    int row = row0 + tok, tpos = row - seqstart;
    const bf16_t* pr = p.P + (size_t)row * PW;
    uint4 conv_out;
    {
      float Bv[8], Cv[8], Xv[8], uc[8], up[8], un[8];
      unpack8(*(const uint4*)(pr + 1024 + ch), Bv);
      unpack8(*(const uint4*)(pr + 1280 + ch), Cv);
      unpack8(*(const uint4*)(pr + 1536 + ch), Xv);
#pragma unroll
      for (int e = 0; e < 8; ++e) uc[e] = Cv[e] * Xv[e];
      if (tpos > 0) {
        unpack8(*(const uint4*)(pr - PW + 1280 + ch), Cv);
        unpack8(*(const uint4*)(pr - PW + 1536 + ch), Xv);
#pragma unroll
        for (int e = 0; e < 8; ++e) up[e] = Cv[e] * Xv[e];
      } else {
#pragma unroll
        for (int e = 0; e < 8; ++e) up[e] = 0.f;
      }
      if (tpos < len - 1) {
        unpack8(*(const uint4*)(pr + PW + 1280 + ch), Cv);
        unpack8(*(const uint4*)(pr + PW + 1536 + ch), Xv);
#pragma unroll
        for (int e = 0; e < 8; ++e) un[e] = Cv[e] * Xv[e];
      } else {
#pragma unroll
        for (int e = 0; e < 8; ++e) un[e] = 0.f;
      }
      float o[8];
#pragma unroll
      for (int e = 0; e < 8; ++e)
        o[e] = Bv[e] * (up[e] * cw[ch + e] + uc[e] * cw[256 + ch + e] + un[e] * cw[512 + ch + e]);
      conv_out = pack8(o);
    }
    {
      int gi = ch >> 6;
      int wdw = 2 << gi;
      int lo = tpos - (wdw >> 1);
      int hi = lo + wdw;
      const int lo0 = lo;
      lo = lo < 0 ? 0 : lo;
      hi = hi > len ? len : hi;
      float sum[8], cur[8];
#pragma unroll
      for (int e = 0; e < 8; ++e) sum[e] = 0.f;
      const bf16_t* base = p.P + (size_t)seqstart * PW + 1792 + ch;
      uint4 tv[16];
#pragma unroll
      for (int q = 0; q < 16; ++q) {
        const int j = lo0 + q;
        const bool ok = (j >= lo) && (j < hi);
        tv[q] = *(const uint4*)(base + (size_t)(ok ? j : tpos) * PW);
      }
#pragma unroll
      for (int q = 0; q < 16; ++q) {
        const int j = lo0 + q;
        const bool ok = (j >= lo) && (j < hi);
        float t8[8];
        unpack8(tv[q], t8);
#pragma unroll
        for (int e = 0; e < 8; ++e) sum[e] += ok ? t8[e] : 0.f;
      }
      unpack8(*(const uint4*)(pr + 1792 + ch), cur);
      float inv = 1.f / (float)(hi - lo);
      float o[8];
#pragma unroll
      for (int e = 0; e < 8; ++e) o[e] = sum[e] * inv - cur[e];
      *(uint4*)(p.BR + (size_t)row * 1024 + 256 + ch) = conv_out;
      *(uint4*)(p.BR + (size_t)row * 1024 + 768 + ch) = pack8(o);
    }
  }
}

__device__ void phase_mix_a(const Params& p, int l, char* smem) {
  const bool lastl = (l == DEPTH - 1);
  {
    SchedDFT S{(const char*)p.Tlat, (const char*)p.FTlat, (int)gridDim.x, (int)blockIdx.x};
    EpiDFT E{(uint4*)p.H, 0};
    gemm_phase((PG8_LAS unsigned char*)smem, 1024, 4096, 8 * 4096, S, E);
  }
  if (!lastl) {
    SchedDFTc S{(const char*)p.Tctx, (const char*)p.FTctx, (int)gridDim.x, (int)blockIdx.x};
    EpiDFT E{(uint4*)p.H, 1};
    gemm_phase((PG8_LAS unsigned char*)smem, 512, 512, 8 * 512, S, E);
  }
  __syncthreads();
  char* vs = smem + __builtin_amdgcn_readfirstlane(threadIdx.x >> 8) * 72704;
  const int n_cp = lastl ? 2048 : 2304;
  const int n_oth = NITEM + n_cp;
  const int nskip = lastl ? 0 : 8;
  if ((int)blockIdx.x < (int)gridDim.x - nskip) {
    const int nv = ((int)gridDim.x - nskip) * 2;
    for (int o = vbid(); o < n_oth; o += nv) {
      if (o < NITEM) ret_kv_item(p, l, o, vs);
      else convpool_unit(p, l, o - NITEM);
    }
  }
}

__device__ void phase_mix_c(const Params& p, int l, char* smem) {
  const bool lastl = (l == DEPTH - 1);
  const int n = lastl ? 512 : NITEM;
  for (int it = vbid(); it < n; it += nvb()) ret_out_item(p, l, it, smem);
  const int nch = lastl ? 2048 : 2048 + 256;
  const int nsk = lastl ? 0 : 64;
  if (vbid() >= nsk) {
    const int nv = nvb() - nsk;
    for (int ch = vbid() - nsk; ch < nch; ch += 2 * nv) dft_sum_pair(p, ch, ch + nv, ch + nv < nch);
  }
}

#define XB_TMO      128
#define XB_XCNT(j)  (256  + 64 * (j))
#define XB_XSUB(j)  (1280 + 64 * (j))
#define XB_XGEN(j)  (2304 + 64 * (j))
#define XB_TOP      3328
#define XB_TOPGEN   3392
#define XCD_BAR_WORDS 3456
#define XB_SPIN_CAP (1u << 20)
#define LAS __attribute__((address_space(3)))

__device__ __forceinline__ unsigned xb_ld(unsigned* p) { return __hip_atomic_load(p, __ATOMIC_RELAXED, __HIP_MEMORY_SCOPE_AGENT); }
__device__ __forceinline__ unsigned xb_add(unsigned* p, unsigned v) { return __hip_atomic_fetch_add(p, v, __ATOMIC_RELAXED, __HIP_MEMORY_SCOPE_AGENT); }
__device__ __forceinline__ unsigned xb_xcc_id() { return (unsigned)__builtin_amdgcn_s_getreg((3 << 11) | 20) & 0xFu; }
#define XB_SPIN(cond, bar) do { unsigned _sp = 0; while (cond) { __builtin_amdgcn_s_sleep(1); \
    if ((++_sp & 255u) == 0u) { if (xb_ld(&(bar)[XB_TMO])) break; if (_sp > XB_SPIN_CAP) { atomicAdd(&(bar)[XB_TMO], 1u); break; } } } } while (0)

struct XcdBarrier { unsigned* bar; unsigned x; volatile LAS unsigned* st; };

__device__ __forceinline__ XcdBarrier xcd_barrier_post(unsigned* bar, volatile LAS unsigned* st) {
  XcdBarrier b; b.bar = bar; b.x = xb_xcc_id(); b.st = st;
  if (threadIdx.x == 0) (void)xb_add(&bar[XB_XCNT(b.x)], 1u);
  return b;
}
__device__ __forceinline__ void xcd_barrier_complete(unsigned* bar, unsigned x, unsigned& nloc, unsigned& nx) {
  const unsigned G = gridDim.x * gridDim.y * gridDim.z;
  unsigned sum, cnt, mine, sp = 0u;
  for (;;) {
    sum = 0u; cnt = 0u; mine = 0u;
#pragma unroll
    for (unsigned j = 0; j < 16; ++j) { const unsigned c = xb_ld(&bar[XB_XCNT(j)]); sum += c; cnt += (c > 0u) ? 1u : 0u; mine = (j == x) ? c : mine; }
    if (sum == G) break;
    __builtin_amdgcn_s_sleep(1);
    if ((++sp & 255u) == 0u) { if (xb_ld(&bar[XB_TMO])) break; if (sp > XB_SPIN_CAP) { atomicAdd(&bar[XB_TMO], 1u); break; } }
  }
  nloc = mine > 0u ? mine : 1u; nx = cnt > 0u ? cnt : 1u;
}
__device__ __forceinline__ void xcd_barrier(const XcdBarrier& b) {
  asm volatile("s_waitcnt vmcnt(0)" ::: "memory");
  __syncthreads();
  if (threadIdx.x == 0) {
    unsigned* bar = b.bar;
    __builtin_amdgcn_s_waitcnt(0);
    unsigned nloc = b.st[0], nx = b.st[1];
    if (nloc == 0u) { xcd_barrier_complete(bar, b.x, nloc, nx); b.st[0] = nloc; b.st[1] = nx; }
    const unsigned old = xb_add(&bar[XB_XSUB(b.x)], 1u);
    const unsigned gen = old / nloc;
    if (old + 1u == (gen + 1u) * nloc) {
      __builtin_amdgcn_fence(__ATOMIC_RELEASE, "agent");
      asm volatile("s_waitcnt vmcnt(0)" ::: "memory");
      const unsigned og = xb_add(&bar[XB_TOP], 1u);
      const unsigned tg = og / nx;
      if (og + 1u == (tg + 1u) * nx) xb_add(&bar[XB_TOPGEN], 1u);
      else XB_SPIN(xb_ld(&bar[XB_TOPGEN]) == tg, bar);
      __builtin_amdgcn_fence(__ATOMIC_ACQUIRE, "agent");
      xb_add(&bar[XB_XGEN(b.x)], 1u);
      asm volatile("s_waitcnt vmcnt(0)" ::: "memory");
    } else {
      XB_SPIN(xb_ld(&bar[XB_XGEN(b.x)]) == gen, bar);
      __builtin_amdgcn_fence(__ATOMIC_ACQUIRE, "agent");
      asm volatile("s_waitcnt vmcnt(0)" ::: "memory");
    }
  }
  __syncthreads();
}

__device__ void run_phase(const Params& p, int ph, char* smem) {
  char* vs = smem + __builtin_amdgcn_readfirstlane(threadIdx.x >> 8) * 72704;
  if (ph == 0) { convert_layer(p, 0, vs, vbid(), nvb(), 0, 1 << 30); build_tables(p, vs); return; }
  if (ph == 1) { rowpass(p, 0, 0); return; }
  int l = (ph - 2) / 10, k = (ph - 2) % 10;
  switch (k) {
    case 0: phase_gemm1(p, l, smem); break;
    case 1: phase_mix_a(p, l, smem); break;
    case 2: ret_scan(p, l); break;
    case 3: phase_mix_c(p, l, vs); break;
    case 4:
    case 5:
    case 8: {
      if (k == 4) phase_branch(p, l, smem);
      else phase_proj(p, l, k == 5 ? 0 : 1, smem);
      if (l + 1 < DEPTH && blockIdx.x >= 32) {
        const int lo = (k == 4) ? 0 : (k == 5 ? 1200 : 2100);
        const int hi = (k == 4) ? 1200 : (k == 5 ? 2100 : (1 << 30));
        __syncthreads();
        convert_layer(p, l + 1, vs, (blockIdx.x - 32) * 2 + __builtin_amdgcn_readfirstlane(threadIdx.x >> 8), (gridDim.x - 32) * 2, lo, hi);
      }
      break;
    }
    case 6: rowpass(p, l, 1); break;
    case 7: phase_up(p, l, smem); break;
    case 9: rowpass(p, l, 2); break;
  }
}

__global__ void __launch_bounds__(512, 2) mega(Params p, int ph_lo, int ph_hi, int coop) {
  __shared__ __attribute__((aligned(16))) char smem[145408];
#if MULTI_LAUNCH
  for (int ph = ph_lo; ph < ph_hi; ++ph) run_phase(p, ph, smem);
#else
  if (coop < 0) cg::this_grid().sync();
  __shared__ uint4 xb_words;
  if (threadIdx.x == 0) xb_words = make_uint4(0u, 0u, 0u, 0u);
  __syncthreads();
  XcdBarrier b = xcd_barrier_post(p.bar, (volatile LAS unsigned*)&xb_words);
  for (int ph = ph_lo; ph < ph_hi; ++ph) {
    run_phase(p, ph, smem);
    if (ph + 1 < ph_hi) xcd_barrier(b);
  }
#endif
}

extern "C" void kernel_launch(void* const* d_in, const int* in_sizes, int n_in, void* d_out, int out_size, void* d_ws,
                              size_t ws_size, hipStream_t stream) {
  Params p{};
  p.x = (const float*)d_in[0]; p.c = (const float*)d_in[1]; p.ctx = (const float*)d_in[2]; p.c_ctx = (const float*)d_in[3];
  p.w_mod = (const float*)d_in[4]; p.b_mod = (const float*)d_in[5]; p.norm_g = (const float*)d_in[6];
  p.w_in = (const float*)d_in[7]; p.ret_decay = (const float*)d_in[8]; p.conv_w = (const float*)d_in[9];
  p.pool_w = (const float*)d_in[10]; p.pool_scale = (const float*)d_in[11]; p.w_branch = (const float*)d_in[12];
  p.w_o = (const float*)d_in[13]; p.ffn_up = (const float*)d_in[14]; p.ffn_down = (const float*)d_in[15];
  p.out = (float*)d_out;
  char* ws = (char*)d_ws;
  size_t off = 0;
  auto take = [&](size_t bytes) { char* r = ws + off; off += (bytes + 255) & ~(size_t)255; return r; };
  p.W1T = (bf16_t*)take((size_t)W1ROWS * 1024 * 2);
  p.WbT = (bf16_t*)take((size_t)4 * 1024 * 256 * 2);
  p.WoT = (bf16_t*)take((size_t)1024 * 1024 * 2);
  p.WupT = (bf16_t*)take((size_t)2 * DFF * 1024 * 2);
  p.WdT = (bf16_t*)take((size_t)1024 * DFF * 2);
  (void)take(WSET * 2);
  p.Tlat = (bf16_t*)take((size_t)2048 * 4096 * 2);
  p.Tctx = (bf16_t*)take((size_t)256 * 512 * 2);
  p.P = (bf16_t*)take((size_t)MTOT * PW * 2);
  p.GT = (uint4*)take((size_t)MTOT * 4096 * 2);
  p.H = (bf16_t*)take((size_t)MTOT * 1024 * 2);
  p.BR = (bf16_t*)take((size_t)MTOT * 1024 * 2);
  p.FTlat = (bf16_t*)take((size_t)256 * 8 * 2 * 2048 * 2);
  p.FTctx = (bf16_t*)take((size_t)256 * 8 * 2 * 256 * 2);
  p.ST = (bf16_t*)take((size_t)NITEM * 2 * 4096 * 2);
  p.rope = (float*)take((size_t)2048 * 64 * 4);
  p.KV = (float*)take((size_t)NITEM * 2 * 4096 * 4);
  p.xc = (float*)take((size_t)MCTX * 1024 * 4);
  p.mod = (float*)take((size_t)DEPTH * 9 * 6144 * 4);
  p.bar = (unsigned*)take((size_t)XCD_BAR_WORDS * 4);
  if (off > ws_size) { fprintf(stderr, "workspace too small: need %zu have %zu\n", off, ws_size); return; }

  static int grid_blocks = 0;
  if (!grid_blocks) {
    int dev = 0, cus = 0, per_cu = 0;
    (void)hipGetDevice(&dev);
    (void)hipDeviceGetAttribute(&cus, hipDeviceAttributeMultiprocessorCount, dev);
    (void)hipOccupancyMaxActiveBlocksPerMultiprocessor(&per_cu, (const void*)mega, 512, 0);
    if (per_cu < 1) per_cu = 1;
    if (per_cu > 1) per_cu = 1;
    grid_blocks = cus * per_cu;
  }
#if MULTI_LAUNCH
  for (int ph = 0; ph < NPHASE; ++ph) {
    hipLaunchKernelGGL(mega, dim3(grid_blocks), dim3(512), 0, stream, p, ph, ph + 1, 0);
  }
#else
  int lo = 0, hi = NPHASE, coop = 1;
  (void)hipMemsetAsync(p.bar, 0, (size_t)XCD_BAR_WORDS * 4, stream);
  void* args[] = {&p, &lo, &hi, &coop};
  hipError_t e = hipLaunchCooperativeKernel((const void*)mega, dim3(grid_blocks), dim3(512), args, 0, stream);
  if (e != hipSuccess) fprintf(stderr, "cooperative launch failed: %s (grid %d)\n", hipGetErrorString(e), grid_blocks);
#endif
}
```

```cpp
#include <hip/hip_runtime.h>
#include <hip/hip_cooperative_groups.h>
#include <stdint.h>
#include <stdio.h>
namespace cg = cooperative_groups;

#ifndef MULTI_LAUNCH
#define MULTI_LAUNCH 0
#endif

typedef unsigned short bf16_t;
typedef __attribute__((ext_vector_type(8))) short bf16x8;
typedef __attribute__((ext_vector_type(4))) float f32x4;

constexpr int DM = 1024, NBATCH = 8, SEQ = 2048, CTXL = 256, DEPTH = 4;
constexpr int MLAT = NBATCH * SEQ;
constexpr int MCTX = NBATCH * CTXL;
constexpr int MTOT = MLAT + MCTX;
constexpr int PW = 2048;
constexpr int W1ROWS = 6656;
constexpr int DFF = 2816;
constexpr int INW = 6400;
constexpr int NITEM = 576;
constexpr float EPSV = 1e-6f;
constexpr size_t ACT_OFF = (size_t)40 * 1024 * 1024;
constexpr int NPHASE = 2 + DEPTH * 10;
constexpr size_t WSET = (size_t)35127296 / 2;

struct Params {
  const float *x, *c, *ctx, *c_ctx, *w_mod, *b_mod, *norm_g, *w_in, *ret_decay, *conv_w, *pool_w, *pool_scale,
      *w_branch, *w_o, *ffn_up, *ffn_down;
  float* out;
  bf16_t *W1T, *WbT, *WoT, *WupT, *WdT, *Tlat, *Tctx, *P, *H, *BR, *FTlat, *FTctx, *ST;
  float *rope, *KV, *xc, *mod;
  unsigned* bar;
  uint4* GT;
};

__device__ __forceinline__ int tidx() {
  int t = threadIdx.x & 255;
  asm volatile("" : "+v"(t));
  return t;
}
__device__ __forceinline__ int tid512() {
  int t = threadIdx.x;
  asm volatile("" : "+v"(t));
  return t;
}
__device__ __forceinline__ int vbid() { return blockIdx.x * 2 + __builtin_amdgcn_readfirstlane(threadIdx.x >> 8); }
__device__ __forceinline__ int nvb() { return gridDim.x * 2; }
__device__ __forceinline__ unsigned short f2bf(float f) {
  unsigned u = __float_as_uint(f);
  u += 0x7fffu + ((u >> 16) & 1u);
  return (unsigned short)(u >> 16);
}
__device__ __forceinline__ float bf2f(unsigned short h) { return __uint_as_float(((unsigned)h) << 16); }
__device__ __forceinline__ unsigned pack2(float a, float b) {
  unsigned r;
  asm("v_cvt_pk_bf16_f32 %0, %1, %2" : "=v"(r) : "v"(a), "v"(b));
  return r;
}
__device__ __forceinline__ float lo2f(unsigned u) { return __uint_as_float(u << 16); }
__device__ __forceinline__ float hi2f(unsigned u) { return __uint_as_float(u & 0xffff0000u); }
__device__ __forceinline__ float sigmoid_(float x) { return __builtin_amdgcn_rcpf(1.f + __expf(-x)); }
__device__ __forceinline__ float silu_(float x) { return x * __builtin_amdgcn_rcpf(1.f + __expf(-x)); }

__device__ __forceinline__ void unpack8(uint4 v, float* o) {
  o[0] = lo2f(v.x); o[1] = hi2f(v.x); o[2] = lo2f(v.y); o[3] = hi2f(v.y);
  o[4] = lo2f(v.z); o[5] = hi2f(v.z); o[6] = lo2f(v.w); o[7] = hi2f(v.w);
}
__device__ __forceinline__ uint4 pack8(const float* o) {
  uint4 v;
  v.x = pack2(o[0], o[1]); v.y = pack2(o[2], o[3]); v.z = pack2(o[4], o[5]); v.w = pack2(o[6], o[7]);
  return v;
}

__device__ __forceinline__ int lds_off(int row, int ch) { return row * 128 + ((ch ^ ((row >> 1) & 7)) << 4); }

__device__ __forceinline__ void zero_acc(f32x4 (&acc)[4][4]) {
#pragma unroll
  for (int i = 0; i < 4; ++i)
#pragma unroll
    for (int j = 0; j < 4; ++j) acc[i][j] = f32x4{0.f, 0.f, 0.f, 0.f};
}

__device__ __forceinline__ void gemm128(const bf16_t* __restrict__ A, int lda, const bf16_t* __restrict__ B, int ldb,
                                        int K, f32x4 (&acc)[4][4], char* smem) {
  const int tid = tidx(), lane = tid & 63, w = tid >> 6, wm = w >> 1, wn = w & 1;
  const int lr = lane & 15, lq = lane >> 4;
  const int srow = tid >> 3, sch = tid & 7;
  uint4 ra[4], rb[4];
  const bf16_t* ap = A + (size_t)srow * lda + sch * 8;
  const bf16_t* bp = B + (size_t)srow * ldb + sch * 8;
#pragma unroll
  for (int i = 0; i < 4; ++i) {
    ra[i] = *(const uint4*)(ap + (size_t)i * 32 * lda);
    rb[i] = *(const uint4*)(bp + (size_t)i * 32 * ldb);
  }
#pragma unroll
  for (int i = 0; i < 4; ++i) {
    *(uint4*)(smem + lds_off(srow + 32 * i, sch)) = ra[i];
    *(uint4*)(smem + 16384 + lds_off(srow + 32 * i, sch)) = rb[i];
  }
  __syncthreads();
  const int nk = K >> 6;
  for (int kt = 0; kt < nk; ++kt) {
    char* cur = smem + (kt & 1) * 32768;
    char* nxt = smem + ((kt + 1) & 1) * 32768;
    const bool more = (kt + 1 < nk);
    if (more) {
      ap += 64; bp += 64;
#pragma unroll
      for (int i = 0; i < 4; ++i) {
        ra[i] = *(const uint4*)(ap + (size_t)i * 32 * lda);
        rb[i] = *(const uint4*)(bp + (size_t)i * 32 * ldb);
      }
    }
#pragma unroll
    for (int ks = 0; ks < 2; ++ks) {
      bf16x8 af[4], bfr[4];
#pragma unroll
      for (int mi = 0; mi < 4; ++mi) af[mi] = *(const bf16x8*)(cur + lds_off(wm * 64 + mi * 16 + lr, ks * 4 + lq));
#pragma unroll
      for (int ni = 0; ni < 4; ++ni)
        bfr[ni] = *(const bf16x8*)(cur + 16384 + lds_off(wn * 64 + ni * 16 + lr, ks * 4 + lq));
#pragma unroll
      for (int mi = 0; mi < 4; ++mi)
#pragma unroll
        for (int ni = 0; ni < 4; ++ni)
          acc[mi][ni] = __builtin_amdgcn_mfma_f32_16x16x32_bf16(af[mi], bfr[ni], acc[mi][ni], 0, 0, 0);
    }
    if (more) {
#pragma unroll
      for (int i = 0; i < 4; ++i) {
        *(uint4*)(nxt + lds_off(srow + 32 * i, sch)) = ra[i];
        *(uint4*)(nxt + 16384 + lds_off(srow + 32 * i, sch)) = rb[i];
      }
    }
    __syncthreads();
  }
}


#define PG8_LAS __attribute__((address_space(3)))
constexpr int G_BM = 256, G_BK = 64, G_HALF = 128, G_HTB = G_HALF * G_BK * 2;
__device__ __forceinline__ int g_lds_byte(int r, int c) { const int st = (r >> 4) * 2 + (c >> 5), rr = r & 15, cc = c & 31, ob = rr * 64 + cc * 2; return st * 1024 + (ob ^ (((ob >> 9) & 1) << 5)); }
__device__ __forceinline__ void g_stage_rc(int b, int& R, int& C) { const int st = b / 1024, sb = b % 1024, swz = sb ^ (((sb >> 9) & 1) << 5); R = (st >> 1) * 16 + swz / 64; C = (st & 1) * 32 + (swz % 64) / 2; }
__device__ __forceinline__ int g_perm32(int rho) { const int n = rho >> 4, i = rho & 15; return 8 * (i >> 2) + 4 * n + (i & 3); }
struct Unit { int pm, pn, kind; };

template <class Epi, class Sched>
__device__ __forceinline__ void gemm_phase(PG8_LAS unsigned char* lds, const int K, const int lda, const int ldb, const Sched& S, const Epi& E) {
  const int tid = tid512(), wid = __builtin_amdgcn_readfirstlane(tid >> 6), lane = tid & 63, wr = wid >> 2, wc = wid & 3, fr = lane & 15, fq = lane >> 4;
  const int nt = K / G_BK;
  unsigned voffA[2], voffB[2];
#pragma unroll
  for (int i = 0; i < 2; ++i) { int R, C; g_stage_rc(tid * 16 + i * 8192, R, C); const int Rb = Epi::PERM ? ((R & ~31) + g_perm32(R & 31)) : R;
    voffA[i] = (unsigned)(R * lda + C) * 2u; voffB[i] = (unsigned)(Rb * ldb + C) * 2u; }
  const size_t kstep = (size_t)(G_BK * 2);
  const size_t hstepA = (size_t)G_HALF * lda * 2, hstepB = (size_t)G_HALF * ldb * 2;
  const unsigned ldsw = (unsigned)wid * 1024u;
  const int aoff = g_lds_byte(wr * 64 + fr, fq * 8), boff = g_lds_byte(wc * 32 + fr, fq * 8);
#define PG8_SA(b, h) (((b) * 2 + (h)) * G_HTB)
#define PG8_SB(b, h) ((4 + (b) * 2 + (h)) * G_HTB)
#define PG8_STAGE(bufoff, gbase, voff) do { _Pragma("unroll") for (int _i = 0; _i < 2; ++_i) \
    __builtin_amdgcn_global_load_lds((const unsigned*)((const char*)(gbase) + (voff)[_i]), (PG8_LAS unsigned*)(lds + (bufoff) + ldsw + _i * 8192), 16, 0, 0); } while (0)
#define PG8_LDA(dst, b, h) do { _Pragma("unroll") for (int m = 0; m < 4; ++m) _Pragma("unroll") for (int k = 0; k < 2; ++k) dst[m][k] = *(const PG8_LAS bf16x8*)(lds + PG8_SA(b, h) + aoff + m * 2048 + k * 1024); } while (0)
#define PG8_LDB(dst, b, h) do { _Pragma("unroll") for (int n = 0; n < 2; ++n) _Pragma("unroll") for (int k = 0; k < 2; ++k) dst[n][k] = *(const PG8_LAS bf16x8*)(lds + PG8_SB(b, h) + boff + n * 2048 + k * 1024); } while (0)
#define PG8_MMA(ai, bj, At, Bt) do { __builtin_amdgcn_s_setprio(1); _Pragma("unroll") for (int m = 0; m < 4; ++m) _Pragma("unroll") for (int n = 0; n < 2; ++n) _Pragma("unroll") for (int k = 0; k < 2; ++k) \
    acc[ai][bj][m][n] = __builtin_amdgcn_mfma_f32_16x16x32_bf16(Bt[n][k], At[m][k], acc[ai][bj][m][n], 0, 0, 0); __builtin_amdgcn_s_setprio(0); } while (0)
#define PG8_WAIT_V(n) asm volatile("s_waitcnt vmcnt(" #n ")" ::: "memory")
#define PG8_WAIT_L(n) asm volatile("s_waitcnt lgkmcnt(" #n ")" ::: "memory")
#define PG8_BAR __builtin_amdgcn_s_barrier()
#define PG8_SCHED __builtin_amdgcn_sched_barrier(0)
  Unit cur, nxt; int ui = 0;
  const bool any = S.next(0, cur);
  if (any) {
    f32x4 acc[2][2][4][2];
#pragma unroll
    for (int a = 0; a < 2; ++a)
#pragma unroll
      for (int b = 0; b < 2; ++b)
#pragma unroll
        for (int m = 0; m < 4; ++m)
#pragma unroll
          for (int n = 0; n < 2; ++n) acc[a][b][m][n] = (f32x4){0.f, 0.f, 0.f, 0.f};
    bf16x8 At[4][2], B0[2][2], B1[2][2];
    const char* cA = S.aptr(cur); const char* cB = S.bptr(cur);
    PG8_WAIT_V(0);
    PG8_STAGE(PG8_SB(0, 0), cB, voffB); PG8_STAGE(PG8_SA(0, 0), cA, voffA); PG8_STAGE(PG8_SB(0, 1), cB + hstepB, voffB); PG8_STAGE(PG8_SA(0, 1), cA + hstepA, voffA);
    if (wr == 1) PG8_BAR;
    PG8_WAIT_V(4); PG8_BAR;
    PG8_STAGE(PG8_SB(1, 0), cB + kstep, voffB); PG8_STAGE(PG8_SA(1, 0), cA + kstep, voffA); PG8_STAGE(PG8_SB(1, 1), cB + hstepB + kstep, voffB);
    PG8_WAIT_V(6); PG8_BAR;
    for (;;) {
      const bool has_next = S.next(ui + 1, nxt);
      const char* nA = has_next ? S.aptr(nxt) : cA; const char* nB = has_next ? S.bptr(nxt) : cB;
      for (int t = 0; t < nt; t += 2) {
        const bool last = (t == nt - 2);
        const char* a1 = cA + (size_t)(t + 1) * kstep;
        const char* a2 = last ? nA : cA + (size_t)(t + 2) * kstep; const char* b2 = last ? nB : cB + (size_t)(t + 2) * kstep;
        const char* a3 = a2 + kstep; const char* b3 = b2 + kstep;
        PG8_LDB(B0, 0, 0); PG8_SCHED; PG8_LDA(At, 0, 0); PG8_STAGE(PG8_SA(1, 1), a1 + hstepA, voffA);
        PG8_WAIT_L(8); PG8_BAR; PG8_WAIT_L(0); PG8_MMA(0, 0, At, B0); PG8_BAR; PG8_SCHED;
        PG8_LDB(B1, 0, 1); PG8_STAGE(PG8_SB(0, 0), b2, voffB);
        PG8_BAR; PG8_WAIT_L(0); PG8_MMA(0, 1, At, B1); PG8_BAR;
        PG8_LDA(At, 0, 1); PG8_STAGE(PG8_SA(0, 0), a2, voffA);
        PG8_BAR; PG8_WAIT_L(0); PG8_MMA(1, 0, At, B0); PG8_BAR; PG8_SCHED;
        PG8_STAGE(PG8_SB(0, 1), b2 + hstepB, voffB);
        PG8_WAIT_V(6); PG8_BAR; PG8_MMA(1, 1, At, B1); PG8_BAR;
        PG8_LDB(B0, 1, 0); PG8_SCHED; PG8_LDA(At, 1, 0); PG8_STAGE(PG8_SA(0, 1), a2 + hstepA, voffA);
        PG8_WAIT_L(8); PG8_BAR; PG8_WAIT_L(0); PG8_MMA(0, 0, At, B0); PG8_BAR; PG8_SCHED;
        PG8_LDB(B1, 1, 1); PG8_STAGE(PG8_SB(1, 0), b3, voffB);
        PG8_BAR; PG8_WAIT_L(0); PG8_MMA(0, 1, At, B1); PG8_BAR;
        PG8_LDA(At, 1, 1); PG8_STAGE(PG8_SA(1, 0), a3, voffA);
        PG8_BAR; PG8_WAIT_L(0); PG8_MMA(1, 0, At, B0); PG8_BAR; PG8_SCHED;
        PG8_STAGE(PG8_SB(1, 1), b3 + hstepB, voffB);
        PG8_WAIT_V(6); PG8_BAR; PG8_MMA(1, 1, At, B1); PG8_BAR;
      }
      const bool do_reset = E(acc, cur, wr, wc, fr, fq);
      if (!has_next) break;
      if (do_reset) {
#pragma unroll
      for (int a = 0; a < 2; ++a)
#pragma unroll
        for (int b = 0; b < 2; ++b)
#pragma unroll
          for (int m = 0; m < 4; ++m)
#pragma unroll
            for (int n = 0; n < 2; ++n) acc[a][b][m][n] = (f32x4){0.f, 0.f, 0.f, 0.f};
      }
      cur = nxt; cA = nA; cB = nB; ++ui;
    }
    PG8_WAIT_V(0);
    if (wr == 0) PG8_BAR;
    PG8_BAR;
  }
#undef PG8_SA
#undef PG8_SB
#undef PG8_STAGE
#undef PG8_LDA
#undef PG8_LDB
#undef PG8_MMA
#undef PG8_WAIT_V
#undef PG8_WAIT_L
#undef PG8_BAR
#undef PG8_SCHED
}

__device__ __forceinline__ void grid_order(int L, int nM, int nN, int& pm, int& pn) {
  const int nwg = nM * nN;
  int wgid = L;
  { const int q = nwg / 8, r = nwg % 8, xcd = wgid % 8, off = wgid / 8; wgid = (xcd < r ? xcd * (q + 1) : r * (q + 1) + (xcd - r) * q) + off; }
  const int nig = 8 * nN, gid = wgid / nig, fm = gid * 8, gsz = (nM - fm) < 8 ? (nM - fm) : 8;
  pm = fm + ((wgid % nig) % gsz); pn = (wgid % nig) / gsz;
}

__device__ __forceinline__ void tile_decode(int t, int NT, int& mt, int& nt) {
  int g = t / (16 * NT), w = t % (16 * NT);
  mt = g * 16 + (w & 15);
  nt = w >> 4;
}

__device__ __forceinline__ void tr_tile(const float* __restrict__ src, int ld_src, int k0, int n0, bf16_t* __restrict__ dst,
                                        int ld_dst, int drow_base, int mode, float* tile) {
  const int tid = tidx();
#pragma unroll
  for (int i = 0; i < 4; ++i) {
    int k = (tid >> 4) + 16 * i, n4 = (tid & 15) * 4;
    const float* sp = src + (size_t)(k0 + k) * ld_src + n0 + n4;
    float4 v;
    v.x = __builtin_nontemporal_load(sp); v.y = __builtin_nontemporal_load(sp + 1); v.z = __builtin_nontemporal_load(sp + 2); v.w = __builtin_nontemporal_load(sp + 3);
    tile[k * 65 + n4 + 0] = v.x; tile[k * 65 + n4 + 1] = v.y; tile[k * 65 + n4 + 2] = v.z; tile[k * 65 + n4 + 3] = v.w;
  }
  __syncthreads();
  const int n = tid >> 2, kseg = (tid & 3) * 16;
  float o[16];
#pragma unroll
  for (int j = 0; j < 16; ++j) o[j] = tile[(kseg + j) * 65 + n];
  int drow;
  if (mode == 0) drow = drow_base + n;
  else {
    int gn = n0 + n;
    int isu = gn >= DFF;
    int j = isu ? gn - DFF : gn;
    drow = (j >> 7) * 256 + isu * 128 + (j & 127);
  }
  bf16_t* d = dst + (size_t)drow * ld_dst + k0 + kseg;
  *(uint4*)d = pack8(o);
  *(uint4*)(d + 8) = pack8(o + 8);
  __syncthreads();
}

__device__ void convert_layer(const Params& p, int l, char* smem, int vb0, int nvbk, int u_lo, int u_hi) {
  float* tile = (float*)smem;
  const int tid = tidx();
  const size_t wo = (size_t)(l & 1) * WSET;
  bf16_t* const W1T = p.W1T + wo; bf16_t* const WbT = p.WbT + wo; bf16_t* const WoT = p.WoT + wo; bf16_t* const WupT = p.WupT + wo; bf16_t* const WdT = p.WdT + wo;
  const int U_IN = 16 * 96, U_BR = 192, U_O = 256, U_UP = 16 * 88, U_DN = 44 * 16, U_FF = 64, U_PF = 64;
  const int total = U_IN + U_BR + U_O + U_UP + U_DN + U_FF + U_PF;
  const float* w_in = p.w_in + (size_t)l * DM * INW;
  const float* w_br = p.w_branch + (size_t)l * 4 * 256 * DM;
  if (u_hi > total) u_hi = total;
  for (int u = u_lo + vb0; u < u_hi; u += nvbk) {
    int v = u;
    if (v < U_IN) {
      int kt = v & 15, ntile = v >> 4;
      int dn0 = ntile * 64;
      int sn0 = dn0 < 1792 ? dn0 : dn0 + 256;
      tr_tile(w_in, INW, kt * 64, sn0, W1T, 1024, dn0, 0, tile);
      continue;
    }
    v -= U_IN;
    if (v < U_BR) {
      int i = v / 64, r = v % 64, kt = r & 3, ntile = r >> 2;
      tr_tile(w_br + (size_t)i * 256 * DM, DM, kt * 64, ntile * 64, WbT + (size_t)i * 1024 * 256, 256, ntile * 64, 0, tile);
      continue;
    }
    v -= U_BR;
    if (v < U_O) {
      int kt = v & 15, ntile = v >> 4;
      tr_tile(p.w_o + (size_t)l * DM * DM, DM, kt * 64, ntile * 64, WoT, 1024, ntile * 64, 0, tile);
      continue;
    }
    v -= U_O;
    if (v < U_UP) {
      int kt = v & 15, ntile = v >> 4;
      tr_tile(p.ffn_up + (size_t)l * DM * 2 * DFF, 2 * DFF, kt * 64, ntile * 64, WupT, 1024, 0, 1, tile);
      continue;
    }
    v -= U_UP;
    if (v < U_DN) {
      int kt = v % 44, ntile = v / 44;
      tr_tile(p.ffn_down + (size_t)l * DFF * DM, DM, kt * 64, ntile * 64, WdT, DFF, ntile * 64, 0, tile);
      continue;
    }
    v -= U_DN;
    if (v < U_FF) {
      int g = v >> 4, kb = v & 15;
      float* tw = tile + 64 * 65;
#pragma unroll
      for (int i = 0; i < 4; ++i) {
        int k = (tid >> 4) + 16 * i, n4 = (tid & 15) * 4;
        float4 vv = *(const float4*)(w_in + (size_t)(kb * 64 + k) * INW + 1792 + g * 64 + n4);
        tile[k * 65 + n4 + 0] = vv.x; tile[k * 65 + n4 + 1] = vv.y; tile[k * 65 + n4 + 2] = vv.z; tile[k * 65 + n4 + 3] = vv.w;
      }
      if (tid < 64) { tw[tid] = cospif(tid / 32.f); tw[64 + tid] = sinpif(tid / 32.f); }
      __syncthreads();
      int kk = tid & 63, kg = tid >> 6;
#pragma unroll 1
      for (int q = 0; q < 16; ++q) {
        int k2 = kg * 16 + q;
        float sc = 0.f, ss = 0.f;
#pragma unroll 4
        for (int cch = 0; cch < 64; ++cch) {
          float wv = tile[kk * 65 + cch];
          int m = (cch * k2) & 63;
          sc += wv * tw[m];
          ss += wv * tw[64 + m];
        }
        W1T[(size_t)(6144 + g * 64 + k2) * 1024 + kb * 64 + kk] = f2bf(sc);
        W1T[(size_t)(6144 + 256 + g * 64 + k2) * 1024 + kb * 64 + kk] = f2bf(ss);
      }
      __syncthreads();
      continue;
    }
    v -= U_FF;
    {
      int g = v >> 4, ob = v & 15;
      float* pw = tile;
      float* wb = tile + 64 * 65;
      const float* pws = p.pool_w + ((size_t)l * 4 + g) * 64 * 64;
      const float* psc = p.pool_scale + (size_t)l * 256 + g * 64;
      const float* wsrc = w_br + (size_t)3 * 256 * DM + (size_t)(g * 64) * DM + ob * 64;
#pragma unroll
      for (int i = 0; i < 4; ++i) {
        int r = (tid >> 4) + 16 * i, n4 = (tid & 15) * 4;
        float4 a = *(const float4*)(pws + r * 64 + n4);
        pw[r * 65 + n4 + 0] = a.x * psc[n4 + 0]; pw[r * 65 + n4 + 1] = a.y * psc[n4 + 1];
        pw[r * 65 + n4 + 2] = a.z * psc[n4 + 2]; pw[r * 65 + n4 + 3] = a.w * psc[n4 + 3];
        float4 b = *(const float4*)(wsrc + (size_t)r * DM + n4);
        wb[r * 65 + n4 + 0] = b.x; wb[r * 65 + n4 + 1] = b.y; wb[r * 65 + n4 + 2] = b.z; wb[r * 65 + n4 + 3] = b.w;
      }
      __syncthreads();
      int ii = tid & 63, og = tid >> 6;
#pragma unroll 1
      for (int q = 0; q < 16; ++q) {
        int oc = og * 16 + q;
        float s = 0.f;
#pragma unroll 4
        for (int o = 0; o < 64; ++o) s += pw[ii * 65 + o] * wb[o * 65 + oc];
        WbT[((size_t)3 * 1024 + ob * 64 + oc) * 256 + g * 64 + ii] = f2bf(s);
      }
      __syncthreads();
    }
  }
}

__device__ void build_tables(const Params& p, char* smem) {
  const int tid = tidx();
  const int U_TW = 4096, U_TC = 64, U_RP = 256, U_MOD = 384;
  const int total = U_TW + U_TC + U_RP + U_MOD;
  for (int u = vbid(); u < total; u += nvb()) {
    int v = u;
    if (v < U_TW) {
      size_t e0 = ((size_t)v * 256 + tid) * 8;
      int k1 = (int)(e0 >> 12), n0 = (int)(e0 & 4095);
      float o[8];
#pragma unroll
      for (int j = 0; j < 8; ++j) {
        int nn = n0 + j;
        int isn = nn >= 2048;
        int n = nn & 2047;
        int m = (k1 * n) & 2047;
        float fr = m * (1.f / 1024.f);
        o[j] = isn ? -sinpif(fr) : cospif(fr);
      }
      *(uint4*)(p.Tlat + e0) = pack8(o);
      continue;
    }
    v -= U_TW;
    if (v < U_TC) {
      size_t e0 = ((size_t)v * 256 + tid) * 8;
      int k1 = (int)(e0 >> 9), n0 = (int)(e0 & 511);
      float o[8];
#pragma unroll
      for (int j = 0; j < 8; ++j) {
        int nn = n0 + j;
        int isn = nn >= 256;
        int n = nn & 255;
        int m = (k1 * n) & 255;
        float fr = m * (1.f / 128.f);
        o[j] = isn ? -sinpif(fr) : cospif(fr);
      }
      *(uint4*)(p.Tctx + e0) = pack8(o);
      continue;
    }
    v -= U_TC;
    if (v < U_RP) {
      int e = v * 256 + tid;
      int n = e >> 5, i = e & 31;
      float freq = powf(10000.f, -(float)(i & 15) / 16.f);
      float pos = (i < 16) ? (float)(n >> 6) : (float)(n & 63);
      float ang = pos * freq;
      p.rope[n * 64 + i] = cosf(ang);
      p.rope[n * 64 + 32 + i] = sinf(ang);
      continue;
    }
    v -= U_RP;
    {
      int l = v / 96, cgp = v % 96;
      float* s = (float*)smem;
      float* red = s + 9 * 1024;
      for (int e = tid; e < 9 * 1024; e += 256) {
        float cv = (e < 8 * 1024) ? p.c[e] : p.c_ctx[e - 8 * 1024];
        s[e] = cv / (1.f + expf(-cv));
      }
      __syncthreads();
      int col = cgp * 64 + (tid & 63), kg = tid >> 6;
      float a[9];
#pragma unroll
      for (int r = 0; r < 9; ++r) a[r] = 0.f;
      const float* wm = p.w_mod + (size_t)l * DM * 6144 + col;
      for (int k0 = kg * 256; k0 < kg * 256 + 256; k0 += 16) {
        float wv[16];
#pragma unroll
        for (int j = 0; j < 16; ++j) wv[j] = wm[(size_t)(k0 + j) * 6144];
#pragma unroll
        for (int j = 0; j < 16; ++j)
#pragma unroll
          for (int r = 0; r < 9; ++r) a[r] += s[r * 1024 + k0 + j] * wv[j];
      }
#pragma unroll
      for (int r = 0; r < 9; ++r) red[(kg * 9 + r) * 64 + (tid & 63)] = a[r];
      __syncthreads();
      for (int o = tid; o < 9 * 64; o += 256) {
        int r = o >> 6, cc = o & 63;
        float sum = red[(0 * 9 + r) * 64 + cc] + red[(1 * 9 + r) * 64 + cc] + red[(2 * 9 + r) * 64 + cc] +
                    red[(3 * 9 + r) * 64 + cc];
        p.mod[((size_t)l * 9 + r) * 6144 + cgp * 64 + cc] = sum + p.b_mod[(size_t)l * 6144 + cgp * 64 + cc];
      }
      __syncthreads();
    }
  }
}

__device__ __forceinline__ float wave_sum(float v) {
#pragma unroll
  for (int o = 32; o >= 1; o >>= 1) v += __shfl_xor(v, o, 64);
  return v;
}

__device__ void rowpass(const Params& p, int l, int mode) {
  const int lane = tidx() & 63;
  const int gw = vbid() * 4 + (tidx() >> 6), nw = nvb() * 4;
  const bool ctx_on = (mode == 0) || (l < DEPTH - 1);
  const int nrows = ctx_on ? MTOT : MLAT;
  const bf16_t* raw = p.P;
  const float* ngbase = p.norm_g;
  const float* modbase = p.mod;
  bf16_t* hbase = p.H;
  asm volatile("" : "+s"(raw), "+s"(ngbase), "+s"(modbase), "+s"(hbase));
  const bool needh = !(mode == 2 && l == DEPTH - 1);
  const int lh = (mode == 2 && l + 1 < DEPTH) ? l + 1 : l;
  const bool first = (l == 0 && mode <= 1);
  const int R = (nrows + nw - 1) / nw;
  const int r_lo = gw * R, r_hi = (r_lo + R < nrows) ? r_lo + R : nrows;
  float ngA[16], ngB[16], gv[16], shv[16], scv[16];
  {
    const float* nga = ngbase + ((size_t)l * 4 + (mode == 1 ? 1 : 3)) * DM;
    const float* ngb = ngbase + ((size_t)lh * 4 + (mode == 1 ? 2 : 0)) * DM;
#pragma unroll
    for (int i = 0; i < 2; ++i)
#pragma unroll
      for (int hh = 0; hh < 2; ++hh) {
        const int o = lane * 8 + 512 * i + 4 * hh, e0 = 8 * i + 4 * hh;
        float4 a4 = *(const float4*)(nga + o);
        float4 b4 = *(const float4*)(ngb + o);
        ngA[e0] = a4.x; ngA[e0 + 1] = a4.y; ngA[e0 + 2] = a4.z; ngA[e0 + 3] = a4.w;
        ngB[e0] = b4.x; ngB[e0 + 1] = b4.y; ngB[e0 + 2] = b4.z; ngB[e0 + 3] = b4.w;
      }
  }
  int cur_m = -1;
  for (int row = r_lo; row < r_hi; ++row) {
    const bool isl = row < MLAT;
    const int mrow = isl ? (row >> 11) : 8;
    if (mrow != cur_m) {
      cur_m = mrow;
      const float* gt = modbase + (l * 9 + mrow) * 6144 + (mode == 1 ? 2048 : 5120);
      const float* mv = modbase + (lh * 9 + mrow) * 6144 + (mode == 1 ? 3072 : 0);
#pragma unroll
      for (int i = 0; i < 2; ++i)
#pragma unroll
        for (int hh = 0; hh < 2; ++hh) {
          const int o = lane * 8 + 512 * i + 4 * hh, e0 = 8 * i + 4 * hh;
          float4 g4 = *(const float4*)(gt + o);
          float4 s4 = *(const float4*)(mv + o);
          float4 c4 = *(const float4*)(mv + 1024 + o);
          gv[e0] = g4.x; gv[e0 + 1] = g4.y; gv[e0 + 2] = g4.z; gv[e0 + 3] = g4.w;
          shv[e0] = s4.x; shv[e0 + 1] = s4.y; shv[e0 + 2] = s4.z; shv[e0 + 3] = s4.w;
          scv[e0] = c4.x; scv[e0 + 1] = c4.y; scv[e0 + 2] = c4.z; scv[e0 + 3] = c4.w;
        }
    }
    const float* xin;
    float* xout;
    if (isl) {
      size_t o = (size_t)row * DM;
      xin = (first ? p.x : p.out) + o;
      xout = p.out + o;
    } else {
      size_t o = (size_t)(row - MLAT) * DM;
      xin = (first ? p.ctx : p.xc) + o;
      xout = p.xc + o;
    }
    float xv[16], rv[16];
#pragma unroll
    for (int i = 0; i < 2; ++i)
#pragma unroll
      for (int hh = 0; hh < 2; ++hh) {
        const int o = lane * 8 + 512 * i + 4 * hh, e0 = 8 * i + 4 * hh;
        float4 t0 = *(const float4*)(xin + o);
        xv[e0] = t0.x; xv[e0 + 1] = t0.y; xv[e0 + 2] = t0.z; xv[e0 + 3] = t0.w;
      }
    if (mode != 0) {
#pragma unroll
      for (int i = 0; i < 2; ++i) unpack8(*(const uint4*)(raw + (size_t)row * DM + lane * 8 + 512 * i), &rv[8 * i]);
      float ss = 0.f;
#pragma unroll
      for (int e = 0; e < 16; ++e) ss += rv[e] * rv[e];
      ss = wave_sum(ss);
      const float rstd = rsqrtf(ss * (1.f / DM) + EPSV);
#pragma unroll
      for (int e = 0; e < 16; ++e) xv[e] += gv[e] * (rv[e] * rstd * ngA[e]);
    }
    uint4 hq[2];
    if (needh) {
      float ss = 0.f;
#pragma unroll
      for (int e = 0; e < 16; ++e) ss += xv[e] * xv[e];
      ss = wave_sum(ss);
      const float rstd = rsqrtf(ss * (1.f / DM) + EPSV);
#pragma unroll
      for (int i = 0; i < 2; ++i) {
        float hv[8];
#pragma unroll
        for (int e = 0; e < 8; ++e) hv[e] = xv[8 * i + e] * rstd * ngB[8 * i + e] * (1.f + scv[8 * i + e]) + shv[8 * i + e];
        hq[i] = pack8(hv);
      }
    }
    if (mode != 0) {
#pragma unroll
      for (int i = 0; i < 2; ++i)
#pragma unroll
        for (int hh = 0; hh < 2; ++hh) {
          const int e0 = 8 * i + 4 * hh;
          float4 o4; o4.x = xv[e0]; o4.y = xv[e0 + 1]; o4.z = xv[e0 + 2]; o4.w = xv[e0 + 3];
          *(float4*)(xout + lane * 8 + 512 * i + 4 * hh) = o4;
        }
    }
    if (needh) {
      bf16_t* hr = hbase + (size_t)row * DM;
#pragma unroll
      for (int i = 0; i < 2; ++i) *(uint4*)(hr + lane * 8 + 512 * i) = hq[i];
    }
  }
}

struct SchedG1 {
  const char* H; const char* W; int nMt, nreg, total, G, c;
  __device__ __forceinline__ bool next(int i, Unit& u) const {
    const int L = i * G + c;
    if (L >= total) return false;
    if (L < nreg) { grid_order(L, nMt, 24, u.pm, u.pn); u.kind = 0; }
    else if (L < nreg + 2 * nMt) { const int v = L - nreg; u.pm = v & 1; u.pn = v >> 1; u.kind = 1; }
    else { const int v = L - nreg - 2 * nMt; u.pm = 64 + (v & 7); u.pn = 1 + (v >> 3); u.kind = 0; }
    return true;
  }
  __device__ __forceinline__ const char* aptr(const Unit& u) const {
    return u.kind == 0 ? H + (size_t)u.pm * 256 * 2048 : W + (size_t)(6144 + u.pm * 256) * 2048;
  }
  __device__ __forceinline__ const char* bptr(const Unit& u) const {
    return u.kind == 0 ? W + (size_t)u.pn * 256 * 2048 : H + (size_t)u.pn * 256 * 2048;
  }
};
struct EpiG1 {
  static constexpr bool PERM = true;
  bf16_t* P; bf16_t* FTlat; bf16_t* FTctx; uint4* GT;
  __device__ __forceinline__ bool operator()(f32x4 (&acc)[2][2][4][2], const Unit& u, int wr, int wc, int fr, int fq) const {
#pragma unroll
    for (int ai = 0; ai < 2; ++ai)
#pragma unroll
      for (int bj = 0; bj < 2; ++bj)
#pragma unroll
        for (int m = 0; m < 4; ++m) {
          const int r = 256 * u.pm + 128 * ai + 64 * wr + 16 * m + fr;
          const int cc = 256 * u.pn + 128 * bj + 32 * wc + 8 * fq;
          f32x4 v0 = acc[ai][bj][m][0], v1 = acc[ai][bj][m][1];
          uint4 pk;
          if (u.kind == 0) {
            if (u.pn >= 8) {
              pk.x = pack2(1.f + __expf(-v0[0]), 1.f + __expf(-v0[1])); pk.y = pack2(1.f + __expf(-v0[2]), 1.f + __expf(-v0[3]));
              pk.z = pack2(1.f + __expf(-v1[0]), 1.f + __expf(-v1[1])); pk.w = pack2(1.f + __expf(-v1[2]), 1.f + __expf(-v1[3]));
              const int tb = 16 * u.pm + 8 * ai + 4 * wr + m;
              const int cb = 8 * (u.pn - 8) + 4 * bj + wc;
              {
                unsigned* gp = (unsigned*)&GT[((size_t)tb * 128 + cb) * 64 + fq * 16 + fr];
                typedef unsigned u32x4nt __attribute__((ext_vector_type(4)));
                u32x4nt vv = {pk.x, pk.y, pk.z, pk.w};
                __builtin_nontemporal_store(vv, (u32x4nt*)gp);
              }
            } else {
              pk.x = pack2(v0[0], v0[1]); pk.y = pack2(v0[2], v0[3]); pk.z = pack2(v1[0], v1[1]); pk.w = pack2(v1[2], v1[3]);
              *(uint4*)(P + (size_t)r * PW + cc) = pk;
            }
          } else {
            const int cs = r >> 8, col = r & 255;
            pk.x = pack2(v0[0], v0[1]); pk.y = pack2(v0[2], v0[3]); pk.z = pack2(v1[0], v1[1]); pk.w = pack2(v1[2], v1[3]);
            if (cc < MLAT) {
              const int bb = cc >> 11, nn = cc & 2047;
              *(uint4*)(FTlat + (((size_t)col * 8 + bb) * 2 + cs) * 2048 + nn) = pk;
            } else {
              const int tk = cc - MLAT;
              const int bb = tk >> 8, nn = tk & 255;
              *(uint4*)(FTctx + (((size_t)col * 8 + bb) * 2 + cs) * 256 + nn) = pk;
            }
          }
        }
    return true;
  }
};
__device__ void phase_gemm1(const Params& p, int l, char* smem) {
  const bool lastl = (l == DEPTH - 1);
  SchedG1 S;
  S.H = (const char*)p.H; S.W = (const char*)(p.W1T + (size_t)(l & 1) * WSET);
  S.nMt = lastl ? 64 : 72;
  S.nreg = S.nMt * 24;
  S.total = S.nreg + 2 * S.nMt + (lastl ? 16 : 0);
  S.G = gridDim.x; S.c = blockIdx.x;
  EpiG1 E{p.P, p.FTlat, p.FTctx, p.GT};
  gemm_phase((PG8_LAS unsigned char*)smem, 1024, 1024, 1024, S, E);
}

struct SchedDFT {
  const char* T; const char* FT; int G, c;
  __device__ __forceinline__ bool next(int i, Unit& u) const {
    const int L = i * G + c;
    if (L >= 256) return false;
    u.kind = L >> 5; u.pm = (L >> 2) & 7; u.pn = L & 3;
    return true;
  }
  __device__ __forceinline__ const char* aptr(const Unit& u) const { return T + ((size_t)u.pm * 256 * 4096 + u.pn * 1024) * 2; }
  __device__ __forceinline__ const char* bptr(const Unit& u) const { return FT + ((size_t)u.kind * 4096 + u.pn * 1024) * 2; }
};
struct SchedDFTc {
  const char* T; const char* FT; int G, c;
  __device__ __forceinline__ bool next(int i, Unit& u) const {
    const int L = i * G + (G - 1 - c);
    if (L >= 8) return false;
    u.kind = L; u.pm = 0; u.pn = 0;
    return true;
  }
  __device__ __forceinline__ const char* aptr(const Unit& u) const { return T; }
  __device__ __forceinline__ const char* bptr(const Unit& u) const { return FT + (size_t)u.kind * 512 * 2; }
};
struct EpiDFT {
  static constexpr bool PERM = true;
  uint4* DP; int ctx;
  __device__ __forceinline__ bool operator()(f32x4 (&acc)[2][2][4][2], const Unit& u, int wr, int wc, int fr, int fq) const {
#pragma unroll
    for (int ai = 0; ai < 2; ++ai)
#pragma unroll
      for (int bj = 0; bj < 2; ++bj)
#pragma unroll
        for (int m = 0; m < 4; ++m) {
          const int tb = ctx ? (u.kind * 16 + 8 * ai + 4 * wr + m) : (u.kind * 128 + 16 * u.pm + 8 * ai + 4 * wr + m);
          const int cb = 4 * bj + wc;
          const size_t base = ctx ? (size_t)4 * 1024 * 8 * 64 : (size_t)u.pn * 1024 * 8 * 64;
          const f32x4 v0 = acc[ai][bj][m][0], v1 = acc[ai][bj][m][1];
          uint4 pk;
          pk.x = pack2(v0[0], v0[1]); pk.y = pack2(v0[2], v0[3]); pk.z = pack2(v1[0], v1[1]); pk.w = pack2(v1[2], v1[3]);
          DP[base + ((size_t)tb * 8 + cb) * 64 + fq * 16 + fr] = pk;
        }
    return true;
  }
};
__device__ __forceinline__ void dft_sum_pair(const Params& p, int chunk0, int chunk1, bool has1) {
  const int tid = tidx();
  const uint4* DP = (const uint4*)p.H;
  const int lane = tid & 63, fr = lane & 15, fq = lane >> 4;
  uint4 v[2][4];
  int token[2], col[2], npart[2];
#pragma unroll
  for (int j = 0; j < 2; ++j) {
    const int chunk = (j == 0) ? chunk0 : (has1 ? chunk1 : chunk0);
    if (chunk < 2048) {
      const int pidx = chunk * 4 + (tid >> 6);
      const int tb = pidx >> 3, cb = pidx & 7;
#pragma unroll
      for (int ks = 0; ks < 4; ++ks) v[j][ks] = DP[(size_t)ks * 1024 * 8 * 64 + (size_t)pidx * 64 + lane];
      token[j] = tb * 16 + fr; col[j] = cb * 32 + fq * 8; npart[j] = 4;
    } else {
      const int pidx = (chunk - 2048) * 4 + (tid >> 6);
      const int tb = pidx >> 3, cb = pidx & 7;
      v[j][0] = DP[(size_t)4 * 1024 * 8 * 64 + (size_t)pidx * 64 + lane];
      v[j][1] = v[j][0]; v[j][2] = v[j][0]; v[j][3] = v[j][0];
      token[j] = MLAT + tb * 16 + fr; col[j] = cb * 32 + fq * 8; npart[j] = 1;
    }
  }
#pragma unroll
  for (int j = 0; j < 2; ++j) {
    if (j == 1 && !has1) break;
    float a[8], t[8];
    unpack8(v[j][0], a);
    if (npart[j] == 4) {
#pragma unroll
      for (int ks = 1; ks < 4; ++ks) {
        unpack8(v[j][ks], t);
#pragma unroll
        for (int e = 0; e < 8; ++e) a[e] += t[e];
      }
    }
    const float sc = (npart[j] == 4) ? 0.00276213586400995f : 0.0078125f;
#pragma unroll
    for (int e = 0; e < 8; ++e) a[e] *= sc;
    *(uint4*)(p.BR + (size_t)token[j] * 1024 + 512 + col[j]) = pack8(a);
  }
}

struct SchedBr {
  const char* BR; const char* Wb; int ntiles, nM, G, c;
  __device__ __forceinline__ bool next(int i, Unit& u) const {
    const int L = (i >> 2) * G + c;
    if (L >= ntiles) return false;
    grid_order(L, nM, 4, u.pm, u.pn); u.kind = i & 3;
    return true;
  }
  __device__ __forceinline__ const char* aptr(const Unit& u) const { return BR + ((size_t)u.pm * 256 * 1024 + u.kind * 256) * 2; }
  __device__ __forceinline__ const char* bptr(const Unit& u) const { return Wb + ((size_t)(u.kind * 1024 + u.pn * 256) * 256) * 2; }
};
struct EpiBr {
  static constexpr bool PERM = true;
  const uint4* __restrict__ GT; bf16_t* __restrict__ H;
  __device__ __forceinline__ bool operator()(f32x4 (&acc)[2][2][4][2], const Unit& u, int wr, int wc, int fr, int fq) const {
    const int seg = u.kind;
    const bool lastseg = (seg == 3);
    int lanei = fq * 16 + fr;
    asm volatile("" : "+v"(lanei));
    const uint4* __restrict__ gbase = GT + ((size_t)(16 * u.pm + 4 * wr) * 128 + seg * 32 + 8 * u.pn + wc) * 64 + lanei;
    const size_t nxt = lastseg ? 0 : (size_t)32 * 64;
    const float keep = lastseg ? 0.f : 1.f;
    uint4 g[2][4], gn[2][4];
#pragma unroll
    for (int m = 0; m < 4; ++m) {
      const uint4* gp = gbase + (size_t)m * 128 * 64;
      g[0][m] = gp[0];
      gn[0][m] = gp[nxt];
    }
#pragma unroll
    for (int c = 0; c < 4; ++c) {
      const int ai = c >> 1, bj = c & 1;
      if (c + 1 < 4) {
        const int ai2 = (c + 1) >> 1, bj2 = (c + 1) & 1;
#pragma unroll
        for (int m = 0; m < 4; ++m) {
          const uint4* gp = gbase + ((size_t)(8 * ai2 + m) * 128 + 4 * bj2) * 64;
          g[(c + 1) & 1][m] = gp[0];
          gn[(c + 1) & 1][m] = gp[nxt];
        }
      }
#pragma unroll
      for (int m = 0; m < 4; ++m) {
        float f[8], fn[8], v[8];
        unpack8(g[c & 1][m], f);
        unpack8(gn[c & 1][m], fn);
#pragma unroll
        for (int e = 0; e < 8; ++e) {
          float ff = __builtin_amdgcn_rcpf(f[e]);
          if (!lastseg) ff *= fn[e];
          v[e] = acc[ai][bj][m][e >> 2][e & 3] * ff;
        }
        if (lastseg) {
          const int r = 256 * u.pm + 128 * ai + 64 * wr + 16 * m + fr;
          const int cc = 256 * u.pn + 128 * bj + 32 * wc + 8 * fq;
          *(uint4*)(H + (size_t)r * 1024 + cc) = pack8(v);
        }
#pragma unroll
        for (int e = 0; e < 8; ++e) acc[ai][bj][m][e >> 2][e & 3] = v[e] * keep;
      }
    }
    return false;
  }
};
__device__ void phase_branch(const Params& p, int l, char* smem) {
  SchedBr S;
  S.BR = (const char*)p.BR; S.Wb = (const char*)(p.WbT + (size_t)(l & 1) * WSET);
  S.nM = (l == DEPTH - 1) ? 64 : 72; S.ntiles = S.nM * 4; S.G = gridDim.x; S.c = blockIdx.x;
  EpiBr E{p.GT, p.H};
  int Kb = 256;
  asm volatile("" : "+s"(Kb));
  gemm_phase((PG8_LAS unsigned char*)smem, Kb, 1024, 256, S, E);
}

struct SchedGrid {
  const char* X; const char* W; int nM, nN, G, c; size_t tstep;
  __device__ __forceinline__ bool next(int i, Unit& u) const {
    const int L = i * G + c;
    if (L >= nM * nN) return false;
    grid_order(L, nM, nN, u.pm, u.pn); u.kind = 0;
    return true;
  }
  __device__ __forceinline__ const char* aptr(const Unit& u) const { return X + (size_t)u.pm * tstep; }
  __device__ __forceinline__ const char* bptr(const Unit& u) const { return W + (size_t)u.pn * tstep; }
};
struct EpiRaw {
  static constexpr bool PERM = true;
  bf16_t* raw;
  __device__ __forceinline__ bool operator()(f32x4 (&acc)[2][2][4][2], const Unit& u, int wr, int wc, int fr, int fq) const {
#pragma unroll
    for (int ai = 0; ai < 2; ++ai)
#pragma unroll
      for (int bj = 0; bj < 2; ++bj)
#pragma unroll
        for (int m = 0; m < 4; ++m) {
          const int r = 256 * u.pm + 128 * ai + 64 * wr + 16 * m + fr;
          const int cc = 256 * u.pn + 128 * bj + 32 * wc + 8 * fq;
          const f32x4 v0 = acc[ai][bj][m][0], v1 = acc[ai][bj][m][1];
          uint4 pk;
          pk.x = pack2(v0[0], v0[1]); pk.y = pack2(v0[2], v0[3]); pk.z = pack2(v1[0], v1[1]); pk.w = pack2(v1[2], v1[3]);
          *(uint4*)(raw + (size_t)r * 1024 + cc) = pk;
        }
    return true;
  }
};
struct EpiSwiglu {
  static constexpr bool PERM = true;
  bf16_t* act;
  __device__ __forceinline__ bool operator()(f32x4 (&acc)[2][2][4][2], const Unit& u, int wr, int wc, int fr, int fq) const {
#pragma unroll
    for (int ai = 0; ai < 2; ++ai)
#pragma unroll
      for (int m = 0; m < 4; ++m) {
        const int r = 256 * u.pm + 128 * ai + 64 * wr + 16 * m + fr;
        const int fcol = 128 * u.pn + 32 * wc + 8 * fq;
        float o[8];
#pragma unroll
        for (int n = 0; n < 2; ++n)
#pragma unroll
          for (int j = 0; j < 4; ++j) o[4 * n + j] = silu_(acc[ai][0][m][n][j]) * acc[ai][1][m][n][j];
        *(uint4*)(act + (size_t)r * DFF + fcol) = pack8(o);
      }
    return true;
  }
};

__device__ void phase_proj(const Params& p, int l, int mode, char* smem) {
  const int K = mode == 0 ? 1024 : DFF;
  SchedGrid S;
  S.X = mode == 0 ? (const char*)p.H : (const char*)(p.P + ACT_OFF);
  S.W = mode == 0 ? (const char*)(p.WoT + (size_t)(l & 1) * WSET) : (const char*)(p.WdT + (size_t)(l & 1) * WSET);
  S.nM = (l == DEPTH - 1) ? 64 : 72; S.nN = 4; S.G = gridDim.x; S.c = blockIdx.x; S.tstep = (size_t)256 * K * 2;
  EpiRaw E{p.P};
  gemm_phase((PG8_LAS unsigned char*)smem, K, K, K, S, E);
}
__device__ void phase_up(const Params& p, int l, char* smem) {
  SchedGrid S;
  S.X = (const char*)p.H; S.W = (const char*)(p.WupT + (size_t)(l & 1) * WSET);
  S.nM = (l == DEPTH - 1) ? 64 : 72; S.nN = 22; S.G = gridDim.x; S.c = blockIdx.x; S.tstep = (size_t)256 * 1024 * 2;
  EpiSwiglu E{p.P + ACT_OFF};
  gemm_phase((PG8_LAS unsigned char*)smem, 1024, 1024, 1024, S, E);
}

__device__ __forceinline__ void item_decode(int it, int& s, int& b, int& h, int& c, int& rowbase, int& pos0) {
  if (it < 512) { s = 0; b = it >> 6; h = (it >> 4) & 3; c = it & 15; rowbase = b * 2048 + c * 128; pos0 = c * 128; }
  else { int v = it - 512; s = 1; b = v >> 3; h = (v >> 1) & 3; c = v & 1; rowbase = MLAT + b * 256 + c * 128; pos0 = 0; }
}
__device__ __forceinline__ float log_sigmoid_(float x) { return -log1pf(expf(-x)); }

__device__ __forceinline__ void load_half(const bf16_t* g, float (&xv)[32]) {
#pragma unroll
  for (int q = 0; q < 4; ++q) unpack8(*(const uint4*)(g + q * 8), &xv[q * 8]);
}
__device__ __forceinline__ void rope_half(float (&xv)[32], const float* tab  ) {
#pragma unroll
  for (int q = 0; q < 4; ++q) {
    float4 c4 = *(const float4*)(tab + q * 4);
    float4 s4 = *(const float4*)(tab + 32 + q * 4);
    float cc[4] = {c4.x, c4.y, c4.z, c4.w}, sn[4] = {s4.x, s4.y, s4.z, s4.w};
#pragma unroll
    for (int e = 0; e < 4; ++e) {
      int i = q * 4 + e;
      float x1 = xv[i], x2 = xv[i + 16];
      xv[i] = x1 * cc[e] - x2 * sn[e];
      xv[i + 16] = x1 * sn[e] + x2 * cc[e];
    }
  }
}

__device__ __forceinline__ void ret_kv_item(const Params& p, int l, int it, char* smem) {
  const int tid = tidx(), lane = tid & 63, w = tid >> 6, lr = lane & 15, lq = lane >> 4;
  int s, b, h, c, rowbase, pos0;
  item_decode(it, s, b, h, c, rowbase, pos0);
  const float lgf = log_sigmoid_(p.ret_decay[(l * 2 + 0) * 4 + h]);
  const float lgb = log_sigmoid_(p.ret_decay[(l * 2 + 1) * 4 + h]);
  bf16_t* AT = (bf16_t*)smem;
  bf16_t* VT = AT + 128 * 136;
  {
    const int j = tid >> 1, half = tid & 1;
    const bf16_t* prow = p.P + (size_t)(rowbase + j) * PW;
    float kv[32];
    load_half(prow + 256 + h * 64 + half * 32, kv);
    if (s == 0) rope_half(kv, p.rope + (size_t)(pos0 + j) * 64 + half * 16);
    float df = expf(lgf * (float)(127 - j)), db = expf(lgb * (float)j);
#pragma unroll
    for (int e = 0; e < 32; ++e) {
      int d = half * 32 + e;
      AT[d * 136 + j] = f2bf(kv[e] * df);
      AT[(64 + d) * 136 + j] = f2bf(kv[e] * db);
    }
    const bf16_t* vsrc = prow + 512 + h * 64 + half * 32;
#pragma unroll
    for (int q = 0; q < 4; ++q) {
      uint4 vv = *(const uint4*)(vsrc + q * 8);
      unsigned uu[4] = {vv.x, vv.y, vv.z, vv.w};
#pragma unroll
      for (int e = 0; e < 4; ++e) {
        int d = half * 32 + q * 8 + e * 2;
        VT[d * 136 + j] = (bf16_t)(uu[e] & 0xffffu);
        VT[(d + 1) * 136 + j] = (bf16_t)(uu[e] >> 16);
      }
    }
  }
  __syncthreads();
  f32x4 acc[2][4];
#pragma unroll
  for (int mi = 0; mi < 2; ++mi)
#pragma unroll
    for (int ni = 0; ni < 4; ++ni) acc[mi][ni] = f32x4{0.f, 0.f, 0.f, 0.f};
#pragma unroll
  for (int ks = 0; ks < 4; ++ks) {
    bf16x8 af[2], bfr[4];
#pragma unroll
    for (int mi = 0; mi < 2; ++mi) af[mi] = *(const bf16x8*)(AT + (w * 32 + mi * 16 + lr) * 136 + ks * 32 + lq * 8);
#pragma unroll
    for (int ni = 0; ni < 4; ++ni) bfr[ni] = *(const bf16x8*)(VT + (ni * 16 + lr) * 136 + ks * 32 + lq * 8);
#pragma unroll
    for (int mi = 0; mi < 2; ++mi)
#pragma unroll
      for (int ni = 0; ni < 4; ++ni)
        acc[mi][ni] = __builtin_amdgcn_mfma_f32_16x16x32_bf16(af[mi], bfr[ni], acc[mi][ni], 0, 0, 0);
  }
  float* kvout = p.KV + (size_t)it * 2 * 4096;
#pragma unroll
  for (int mi = 0; mi < 2; ++mi)
#pragma unroll
    for (int ni = 0; ni < 4; ++ni) {
      int r = w * 32 + mi * 16 + lq * 4;
      int dir = r >> 6, d = r & 63;
      int v = ni * 16 + lr;
      float4 o;
      o.x = acc[mi][ni][0]; o.y = acc[mi][ni][1]; o.z = acc[mi][ni][2]; o.w = acc[mi][ni][3];
      *(float4*)(kvout + (size_t)dir * 4096 + v * 64 + d) = o;
    }
  __syncthreads();
}

__device__ void ret_scan(const Params& p, int l) {
  const int total = NBATCH * 4 * 2 * 4096;
  for (int e = vbid() * 256 + tidx(); e < total; e += nvb() * 256) {
    int vd = e & 4095, dir = (e >> 12) & 1, h = (e >> 13) & 3, b = e >> 15;
    float lg = log_sigmoid_(p.ret_decay[(l * 2 + dir) * 4 + h]);
    float cd = expf(lg * 128.f);
    float S = 0.f;
    for (int st = 0; st < 18; ++st) {
      int it;
      if (dir == 0) it = (st < 2) ? 512 + ((b * 4 + h) * 2 + st) : ((b * 4 + h) * 16 + (st - 2));
      else it = (st < 2) ? 512 + ((b * 4 + h) * 2 + (1 - st)) : ((b * 4 + h) * 16 + (17 - st));
      size_t o = ((size_t)it * 2 + dir) * 4096 + vd;
      p.ST[o] = f2bf(S);
      S = S * cd + p.KV[o];
    }
  }
}

__device__ __forceinline__ void ret_out_item(const Params& p, int l, int it, char* smem) {
  const int tid = tidx(), lane = tid & 63, w = tid >> 6, lr = lane & 15, lq = lane >> 4;
  int s, b, h, c, rowbase, pos0;
  item_decode(it, s, b, h, c, rowbase, pos0);
  const float lgf = log_sigmoid_(p.ret_decay[(l * 2 + 0) * 4 + h]);
  const float lgb = log_sigmoid_(p.ret_decay[(l * 2 + 1) * 4 + h]);
  bf16_t* Qs = (bf16_t*)smem;
  bf16_t* Ks = Qs + 128 * 72;
  bf16_t* Ps = (bf16_t*)smem;
  bf16_t* VT = (bf16_t*)(smem + 36864);
  bf16_t* Ss = (bf16_t*)(smem + 54272);
  {
    const int j = tid >> 1, half = tid & 1;
    const bf16_t* prow = p.P + (size_t)(rowbase + j) * PW;
    const float* tab = p.rope + (size_t)(pos0 + j) * 64 + half * 16;
    float xv[32];
    load_half(prow + h * 64 + half * 32, xv);
    if (s == 0) rope_half(xv, tab);
#pragma unroll
    for (int e = 0; e < 32; ++e) xv[e] *= 0.125f;
#pragma unroll
    for (int q = 0; q < 4; ++q) *(uint4*)(Qs + j * 72 + half * 32 + q * 8) = pack8(&xv[q * 8]);
    load_half(prow + 256 + h * 64 + half * 32, xv);
    if (s == 0) rope_half(xv, tab);
#pragma unroll
    for (int q = 0; q < 4; ++q) *(uint4*)(Ks + j * 72 + half * 32 + q * 8) = pack8(&xv[q * 8]);
    const bf16_t* vsrc = prow + 512 + h * 64 + half * 32;
#pragma unroll
    for (int q = 0; q < 4; ++q) {
      uint4 vv = *(const uint4*)(vsrc + q * 8);
      unsigned uu[4] = {vv.x, vv.y, vv.z, vv.w};
#pragma unroll
      for (int e = 0; e < 4; ++e) {
        int d = half * 32 + q * 8 + e * 2;
        VT[d * 136 + j] = (bf16_t)(uu[e] & 0xffffu);
        VT[(d + 1) * 136 + j] = (bf16_t)(uu[e] >> 16);
      }
    }
    const bf16_t* st = p.ST + (size_t)it * 2 * 4096;
#pragma unroll
    for (int q = 0; q < 4; ++q) {
      int ch = tid + 256 * q;
      int rowi = ch >> 3, cc = ch & 7;
      *(uint4*)(Ss + rowi * 72 + cc * 8) = *(const uint4*)(st + (size_t)rowi * 64 + cc * 8);
    }
  }
  __syncthreads();
  const int i0 = w * 32;
  uint4 gq[4];
  {
    const bf16_t* gp0 = p.P + (size_t)(rowbase + i0 + (lane >> 1)) * PW + 768 + h * 64 + (lane & 1) * 32;
#pragma unroll
    for (int q = 0; q < 4; ++q) gq[q] = *(const uint4*)(gp0 + q * 8);
  }
  bf16x8 qf[2][2];
#pragma unroll
  for (int mi = 0; mi < 2; ++mi)
#pragma unroll
    for (int ks = 0; ks < 2; ++ks) qf[mi][ks] = *(const bf16x8*)(Qs + (i0 + mi * 16 + lr) * 72 + ks * 32 + lq * 8);
  f32x4 sacc[2][8];
#pragma unroll
  for (int mi = 0; mi < 2; ++mi)
#pragma unroll
    for (int nj = 0; nj < 8; ++nj) sacc[mi][nj] = f32x4{0.f, 0.f, 0.f, 0.f};
#pragma unroll
  for (int nj = 0; nj < 8; ++nj)
#pragma unroll
    for (int ks = 0; ks < 2; ++ks) {
      bf16x8 kf = *(const bf16x8*)(Ks + (nj * 16 + lr) * 72 + ks * 32 + lq * 8);
#pragma unroll
      for (int mi = 0; mi < 2; ++mi) sacc[mi][nj] = __builtin_amdgcn_mfma_f32_16x16x32_bf16(qf[mi][ks], kf, sacc[mi][nj], 0, 0, 0);
    }
  __syncthreads();
#pragma unroll
  for (int mi = 0; mi < 2; ++mi)
#pragma unroll
    for (int nj = 0; nj < 8; ++nj)
#pragma unroll
      for (int r = 0; r < 4; ++r) {
        int i = i0 + mi * 16 + lq * 4 + r, j = nj * 16 + lr;
        float dd = (i >= j) ? __expf(lgf * (float)(i - j)) : __expf(lgb * (float)(j - i));
        Ps[i * 136 + j] = f2bf(sacc[mi][nj][r] * dd);
      }
  __syncthreads();
  f32x4 accF[2][4], accB[2][4], acc1[2][4];
#pragma unroll
  for (int mi = 0; mi < 2; ++mi)
#pragma unroll
    for (int nv = 0; nv < 4; ++nv) {
      accF[mi][nv] = f32x4{0.f, 0.f, 0.f, 0.f};
      accB[mi][nv] = f32x4{0.f, 0.f, 0.f, 0.f};
      acc1[mi][nv] = f32x4{0.f, 0.f, 0.f, 0.f};
    }
#pragma unroll
  for (int nv = 0; nv < 4; ++nv)
#pragma unroll
    for (int ks = 0; ks < 2; ++ks) {
      bf16x8 sf = *(const bf16x8*)(Ss + (nv * 16 + lr) * 72 + ks * 32 + lq * 8);
      bf16x8 sb = *(const bf16x8*)(Ss + (64 + nv * 16 + lr) * 72 + ks * 32 + lq * 8);
#pragma unroll
      for (int mi = 0; mi < 2; ++mi) {
        accF[mi][nv] = __builtin_amdgcn_mfma_f32_16x16x32_bf16(qf[mi][ks], sf, accF[mi][nv], 0, 0, 0);
        accB[mi][nv] = __builtin_amdgcn_mfma_f32_16x16x32_bf16(qf[mi][ks], sb, accB[mi][nv], 0, 0, 0);
      }
    }
#pragma unroll
  for (int ks = 0; ks < 4; ++ks) {
    bf16x8 pf[2], vf[4];
#pragma unroll
    for (int mi = 0; mi < 2; ++mi) pf[mi] = *(const bf16x8*)(Ps + (i0 + mi * 16 + lr) * 136 + ks * 32 + lq * 8);
#pragma unroll
    for (int nv = 0; nv < 4; ++nv) vf[nv] = *(const bf16x8*)(VT + (nv * 16 + lr) * 136 + ks * 32 + lq * 8);
#pragma unroll
    for (int mi = 0; mi < 2; ++mi)
#pragma unroll
      for (int nv = 0; nv < 4; ++nv) acc1[mi][nv] = __builtin_amdgcn_mfma_f32_16x16x32_bf16(pf[mi], vf[nv], acc1[mi][nv], 0, 0, 0);
  }
#pragma unroll
  for (int mi = 0; mi < 2; ++mi)
#pragma unroll
    for (int r = 0; r < 4; ++r) {
      int i = i0 + mi * 16 + lq * 4 + r;
      float qd = __expf(lgf * (float)(i + 1)), qb = __expf(lgb * (float)(128 - i));
      float* yr = (float*)(smem + i * 272);
#pragma unroll
      for (int nv = 0; nv < 4; ++nv) yr[nv * 16 + lr] = acc1[mi][nv][r] + qd * accF[mi][nv][r] + qb * accB[mi][nv][r];
    }
  __syncthreads();
  {
    const int i = i0 + (lane >> 1), half = lane & 1;
    const float* yr = (const float*)(smem + i * 272) + half * 32;
    float y[32];
#pragma unroll
    for (int q = 0; q < 8; ++q) {
      float4 t4 = *(const float4*)(yr + q * 4);
      y[q * 4 + 0] = t4.x; y[q * 4 + 1] = t4.y; y[q * 4 + 2] = t4.z; y[q * 4 + 3] = t4.w;
    }
    float sum = 0.f;
#pragma unroll
    for (int e = 0; e < 32; ++e) sum += y[e];
    sum += __shfl_xor(sum, 1, 64);
    float mu = sum * (1.f / 64.f);
    float vs = 0.f;
#pragma unroll
    for (int e = 0; e < 32; ++e) { y[e] -= mu; vs += y[e] * y[e]; }
    vs += __shfl_xor(vs, 1, 64);
    float rstd = rsqrtf(vs * (1.f / 64.f) + EPSV);
    size_t row = (size_t)(rowbase + i);
    bf16_t* op = p.BR + row * 1024 + h * 64 + half * 32;
#pragma unroll
    for (int q = 0; q < 4; ++q) {
      float g8[8], o8[8];
      unpack8(gq[q], g8);
#pragma unroll
      for (int e = 0; e < 8; ++e) o8[e] = y[q * 8 + e] * rstd * silu_(g8[e]);
      *(uint4*)(op + q * 8) = pack8(o8);
    }
  }
  __syncthreads();
}

__device__ __forceinline__ void convpool_unit(const Params& p, int l, int u) {
  const int tid = tidx();
  const int row0 = u * 8;
  int seqstart, len;
  if (row0 < MLAT) { seqstart = (row0 >> 11) << 11; len = SEQ; }
  else { seqstart = MLAT + (((row0 - MLAT) >> 8) << 8); len = CTXL; }
  const float* cw = p.conv_w + (size_t)l * 3 * 256;
  for (int itx = 0; itx < 1; ++itx) {
    int idx = tid + 256 * itx;
    int tok = idx >> 5, cgp = idx & 31, ch = cgp * 8;
    int row = row0 + tok, tpos = row - seqstart;
    const bf16_t* pr = p.P + (size_t)row * PW;
    uint4 conv_out;
    {
      float Bv[8], Cv[8], Xv[8], uc[8], up[8], un[8];
      unpack8(*(const uint4*)(pr + 1024 + ch), Bv);
      unpack8(*(const uint4*)(pr + 1280 + ch), Cv);
      unpack8(*(const uint4*)(pr + 1536 + ch), Xv);
#pragma unroll
      for (int e = 0; e < 8; ++e) uc[e] = Cv[e] * Xv[e];
      if (tpos > 0) {
        unpack8(*(const uint4*)(pr - PW + 1280 + ch), Cv);
        unpack8(*(const uint4*)(pr - PW + 1536 + ch), Xv);
#pragma unroll
        for (int e = 0; e < 8; ++e) up[e] = Cv[e] * Xv[e];
      } else {
#pragma unroll
        for (int e = 0; e < 8; ++e) up[e] = 0.f;
      }
      if (tpos < len - 1) {
        unpack8(*(const uint4*)(pr + PW + 1280 + ch), Cv);
        unpack8(*(const uint4*)(pr + PW + 1536 + ch), Xv);
#pragma unroll
        for (int e = 0; e < 8; ++e) un[e] = Cv[e] * Xv[e];
      } else {
#pragma unroll
        for (int e = 0; e < 8; ++e) un[e] = 0.f;
      }
      float o[8];
#pragma unroll
      for (int e = 0; e < 8; ++e)
        o[e] = Bv[e] * (up[e] * cw[ch + e] + uc[e] * cw[256 + ch + e] + un[e] * cw[512 + ch + e]);
      conv_out = pack8(o);
    }
    {
      int gi = ch >> 6;
      int wdw = 2 << gi;
      int lo = tpos - (wdw >> 1);
      int hi = lo + wdw;
      const int lo0 = lo;
      lo = lo < 0 ? 0 : lo;
      hi = hi > len ? len : hi;
      float sum[8], cur[8];
#pragma unroll
      for (int e = 0; e < 8; ++e) sum[e] = 0.f;
      const bf16_t* base = p.P + (size_t)seqstart * PW + 1792 + ch;
      uint4 tv[16];
#pragma unroll
      for (int q = 0; q < 16; ++q) {
        const int j = lo0 + q;
        const bool ok = (j >= lo) && (j < hi);
        tv[q] = *(const uint4*)(base + (size_t)(ok ? j : tpos) * PW);
      }
#pragma unroll
      for (int q = 0; q < 16; ++q) {
        const int j = lo0 + q;
        const bool ok = (j >= lo) && (j < hi);
        float t8[8];
        unpack8(tv[q], t8);
#pragma unroll
        for (int e = 0; e < 8; ++e) sum[e] += ok ? t8[e] : 0.f;
      }
      unpack8(*(const uint4*)(pr + 1792 + ch), cur);
      float inv = 1.f / (float)(hi - lo);
      float o[8];
#pragma unroll
      for (int e = 0; e < 8; ++e) o[e] = sum[e] * inv - cur[e];
      *(uint4*)(p.BR + (size_t)row * 1024 + 256 + ch) = conv_out;
      *(uint4*)(p.BR + (size_t)row * 1024 + 768 + ch) = pack8(o);
    }
  }
}

__device__ void phase_mix_a(const Params& p, int l, char* smem) {
  const bool lastl = (l == DEPTH - 1);
  {
    SchedDFT S{(const char*)p.Tlat, (const char*)p.FTlat, (int)gridDim.x, (int)blockIdx.x};
    EpiDFT E{(uint4*)p.H, 0};
    gemm_phase((PG8_LAS unsigned char*)smem, 1024, 4096, 8 * 4096, S, E);
  }
  if (!lastl) {
    SchedDFTc S{(const char*)p.Tctx, (const char*)p.FTctx, (int)gridDim.x, (int)blockIdx.x};
    EpiDFT E{(uint4*)p.H, 1};
    gemm_phase((PG8_LAS unsigned char*)smem, 512, 512, 8 * 512, S, E);
  }
  __syncthreads();
  char* vs = smem + __builtin_amdgcn_readfirstlane(threadIdx.x >> 8) * 72704;
  const int n_cp = lastl ? 2048 : 2304;
  const int n_oth = NITEM + n_cp;
  const int nskip = lastl ? 0 : 8;
  if ((int)blockIdx.x < (int)gridDim.x - nskip) {
    const int nv = ((int)gridDim.x - nskip) * 2;
    for (int o = vbid(); o < n_oth; o += nv) {
      if (o < NITEM) ret_kv_item(p, l, o, vs);
      else convpool_unit(p, l, o - NITEM);
    }
  }
}

__device__ void phase_mix_c(const Params& p, int l, char* smem) {
  const bool lastl = (l == DEPTH - 1);
  const int n = lastl ? 512 : NITEM;
  for (int it = vbid(); it < n; it += nvb()) ret_out_item(p, l, it, smem);
  const int nch = lastl ? 2048 : 2048 + 256;
  for (int ch = vbid(); ch < nch; ch += 2 * nvb()) dft_sum_pair(p, ch, ch + nvb(), ch + nvb() < nch);
}

#define XB_TMO      128
#define XB_XCNT(j)  (256  + 64 * (j))
#define XB_XSUB(j)  (1280 + 64 * (j))
#define XB_XGEN(j)  (2304 + 64 * (j))
#define XB_TOP      3328
#define XB_TOPGEN   3392
#define XCD_BAR_WORDS 3456
#define XB_SPIN_CAP (1u << 20)
#define LAS __attribute__((address_space(3)))

__device__ __forceinline__ unsigned xb_ld(unsigned* p) { return __hip_atomic_load(p, __ATOMIC_RELAXED, __HIP_MEMORY_SCOPE_AGENT); }
__device__ __forceinline__ unsigned xb_add(unsigned* p, unsigned v) { return __hip_atomic_fetch_add(p, v, __ATOMIC_RELAXED, __HIP_MEMORY_SCOPE_AGENT); }
__device__ __forceinline__ unsigned xb_xcc_id() { return (unsigned)__builtin_amdgcn_s_getreg((3 << 11) | 20) & 0xFu; }
#define XB_SPIN(cond, bar) do { unsigned _sp = 0; while (cond) { __builtin_amdgcn_s_sleep(1); \
    if ((++_sp & 255u) == 0u) { if (xb_ld(&(bar)[XB_TMO])) break; if (_sp > XB_SPIN_CAP) { atomicAdd(&(bar)[XB_TMO], 1u); break; } } } } while (0)

struct XcdBarrier { unsigned* bar; unsigned x; volatile LAS unsigned* st; };

__device__ __forceinline__ XcdBarrier xcd_barrier_post(unsigned* bar, volatile LAS unsigned* st) {
  XcdBarrier b; b.bar = bar; b.x = xb_xcc_id(); b.st = st;
  if (threadIdx.x == 0) (void)xb_add(&bar[XB_XCNT(b.x)], 1u);
  return b;
}
__device__ __forceinline__ void xcd_barrier_complete(unsigned* bar, unsigned x, unsigned& nloc, unsigned& nx) {
  const unsigned G = gridDim.x * gridDim.y * gridDim.z;
  unsigned sum, cnt, mine, sp = 0u;
  for (;;) {
    sum = 0u; cnt = 0u; mine = 0u;
#pragma unroll
    for (unsigned j = 0; j < 16; ++j) { const unsigned c = xb_ld(&bar[XB_XCNT(j)]); sum += c; cnt += (c > 0u) ? 1u : 0u; mine = (j == x) ? c : mine; }
    if (sum == G) break;
    __builtin_amdgcn_s_sleep(1);
    if ((++sp & 255u) == 0u) { if (xb_ld(&bar[XB_TMO])) break; if (sp > XB_SPIN_CAP) { atomicAdd(&bar[XB_TMO], 1u); break; } }
  }
  nloc = mine > 0u ? mine : 1u; nx = cnt > 0u ? cnt : 1u;
}
__device__ __forceinline__ void xcd_barrier(const XcdBarrier& b) {
  asm volatile("s_waitcnt vmcnt(0)" ::: "memory");
  __syncthreads();
  if (threadIdx.x == 0) {
    unsigned* bar = b.bar;
    __builtin_amdgcn_s_waitcnt(0);
    unsigned nloc = b.st[0], nx = b.st[1];
    if (nloc == 0u) { xcd_barrier_complete(bar, b.x, nloc, nx); b.st[0] = nloc; b.st[1] = nx; }
    const unsigned old = xb_add(&bar[XB_XSUB(b.x)], 1u);
    const unsigned gen = old / nloc;
    if (old + 1u == (gen + 1u) * nloc) {
      __builtin_amdgcn_fence(__ATOMIC_RELEASE, "agent");
      asm volatile("s_waitcnt vmcnt(0)" ::: "memory");
      const unsigned og = xb_add(&bar[XB_TOP], 1u);
      const unsigned tg = og / nx;
      if (og + 1u == (tg + 1u) * nx) xb_add(&bar[XB_TOPGEN], 1u);
      else XB_SPIN(xb_ld(&bar[XB_TOPGEN]) == tg, bar);
      __builtin_amdgcn_fence(__ATOMIC_ACQUIRE, "agent");
      xb_add(&bar[XB_XGEN(b.x)], 1u);
      asm volatile("s_waitcnt vmcnt(0)" ::: "memory");
    } else {
      XB_SPIN(xb_ld(&bar[XB_XGEN(b.x)]) == gen, bar);
      __builtin_amdgcn_fence(__ATOMIC_ACQUIRE, "agent");
      asm volatile("s_waitcnt vmcnt(0)" ::: "memory");
    }
  }
  __syncthreads();
}

__device__ void run_phase(const Params& p, int ph, char* smem) {
  char* vs = smem + __builtin_amdgcn_readfirstlane(threadIdx.x >> 8) * 72704;
  if (ph == 0) { convert_layer(p, 0, vs, vbid(), nvb(), 0, 1 << 30); build_tables(p, vs); return; }
  if (ph == 1) { rowpass(p, 0, 0); return; }
  int l = (ph - 2) / 10, k = (ph - 2) % 10;
  switch (k) {
    case 0: phase_gemm1(p, l, smem); break;
    case 1: phase_mix_a(p, l, smem); break;
    case 2: ret_scan(p, l); break;
    case 3: phase_mix_c(p, l, vs); break;
    case 4:
    case 5:
    case 8: {
      if (k == 4) phase_branch(p, l, smem);
      else phase_proj(p, l, k == 5 ? 0 : 1, smem);
      if (l + 1 < DEPTH && blockIdx.x >= 32) {
        const int lo = (k == 4) ? 0 : (k == 5 ? 1200 : 2100);
        const int hi = (k == 4) ? 1200 : (k == 5 ? 2100 : (1 << 30));
        __syncthreads();
        convert_layer(p, l + 1, vs, (blockIdx.x - 32) * 2 + __builtin_amdgcn_readfirstlane(threadIdx.x >> 8), (gridDim.x - 32) * 2, lo, hi);
      }
      break;
    }
    case 6: rowpass(p, l, 1); break;
    case 7: phase_up(p, l, smem); break;
    case 9: rowpass(p, l, 2); break;
  }
}

__global__ void __launch_bounds__(512, 2) mega(Params p, int ph_lo, int ph_hi, int coop) {
  __shared__ __attribute__((aligned(16))) char smem[145408];
#if MULTI_LAUNCH
  for (int ph = ph_lo; ph < ph_hi; ++ph) run_phase(p, ph, smem);
#else
  if (coop < 0) cg::this_grid().sync();
  __shared__ uint4 xb_words;
  if (threadIdx.x == 0) xb_words = make_uint4(0u, 0u, 0u, 0u);
  __syncthreads();
  XcdBarrier b = xcd_barrier_post(p.bar, (volatile LAS unsigned*)&xb_words);
  for (int ph = ph_lo; ph < ph_hi; ++ph) {
    run_phase(p, ph, smem);
    if (ph + 1 < ph_hi) xcd_barrier(b);
  }
#endif
}

extern "C" void kernel_launch(void* const* d_in, const int* in_sizes, int n_in, void* d_out, int out_size, void* d_ws,
                              size_t ws_size, hipStream_t stream) {
  Params p{};
  p.x = (const float*)d_in[0]; p.c = (const float*)d_in[1]; p.ctx = (const float*)d_in[2]; p.c_ctx = (const float*)d_in[3];
  p.w_mod = (const float*)d_in[4]; p.b_mod = (const float*)d_in[5]; p.norm_g = (const float*)d_in[6];
  p.w_in = (const float*)d_in[7]; p.ret_decay = (const float*)d_in[8]; p.conv_w = (const float*)d_in[9];
  p.pool_w = (const float*)d_in[10]; p.pool_scale = (const float*)d_in[11]; p.w_branch = (const float*)d_in[12];
  p.w_o = (const float*)d_in[13]; p.ffn_up = (const float*)d_in[14]; p.ffn_down = (const float*)d_in[15];
  p.out = (float*)d_out;
  char* ws = (char*)d_ws;
  size_t off = 0;
  auto take = [&](size_t bytes) { char* r = ws + off; off += (bytes + 255) & ~(size_t)255; return r; };
  p.W1T = (bf16_t*)take((size_t)W1ROWS * 1024 * 2);
  p.WbT = (bf16_t*)take((size_t)4 * 1024 * 256 * 2);
  p.WoT = (bf16_t*)take((size_t)1024 * 1024 * 2);
  p.WupT = (bf16_t*)take((size_t)2 * DFF * 1024 * 2);
  p.WdT = (bf16_t*)take((size_t)1024 * DFF * 2);
  (void)take(WSET * 2);
  p.Tlat = (bf16_t*)take((size_t)2048 * 4096 * 2);
  p.Tctx = (bf16_t*)take((size_t)256 * 512 * 2);
  p.P = (bf16_t*)take((size_t)MTOT * PW * 2);
  p.GT = (uint4*)take((size_t)MTOT * 4096 * 2);
  p.H = (bf16_t*)take((size_t)MTOT * 1024 * 2);
  p.BR = (bf16_t*)take((size_t)MTOT * 1024 * 2);
  p.FTlat = (bf16_t*)take((size_t)256 * 8 * 2 * 2048 * 2);
  p.FTctx = (bf16_t*)take((size_t)256 * 8 * 2 * 256 * 2);
  p.ST = (bf16_t*)take((size_t)NITEM * 2 * 4096 * 2);
  p.rope = (float*)take((size_t)2048 * 64 * 4);
  p.KV = (float*)take((size_t)NITEM * 2 * 4096 * 4);
  p.xc = (float*)take((size_t)MCTX * 1024 * 4);
  p.mod = (float*)take((size_t)DEPTH * 9 * 6144 * 4);
  p.bar = (unsigned*)take((size_t)XCD_BAR_WORDS * 4);
  if (off > ws_size) { fprintf(stderr, "workspace too small: need %zu have %zu\n", off, ws_size); return; }

  static int grid_blocks = 0;
  if (!grid_blocks) {
    int dev = 0, cus = 0, per_cu = 0;
    (void)hipGetDevice(&dev);
    (void)hipDeviceGetAttribute(&cus, hipDeviceAttributeMultiprocessorCount, dev);
    (void)hipOccupancyMaxActiveBlocksPerMultiprocessor(&per_cu, (const void*)mega, 512, 0);
    if (per_cu < 1) per_cu = 1;
    if (per_cu > 1) per_cu = 1;
    grid_blocks = cus * per_cu;
  }
#if MULTI_LAUNCH
  for (int ph = 0; ph < NPHASE; ++ph) {
    hipLaunchKernelGGL(mega, dim3(grid_blocks), dim3(512), 0, stream, p, ph, ph + 1, 0);
  }
#else
  int lo = 0, hi = NPHASE, coop = 1;
  (void)hipMemsetAsync(p.bar, 0, (size_t)XCD_BAR_WORDS * 4, stream);
  void* args[] = {&p, &lo, &hi, &coop};
  hipError_t e = hipLaunchCooperativeKernel((const void*)mega, dim3(grid_blocks), dim3(512), args, 0, stream);
  if (e != hipSuccess) fprintf(stderr, "cooperative launch failed: %s (grid %d)\n", hipGetErrorString(e), grid_blocks);
#endif
}
```
